# Optimizing an MI355X kernel written in HIP

```python
import math
import jax, jax.numpy as jnp
from jax import lax
import numpy as np

D_MODEL = 2048
BATCH = 2
SEQ = 4096
DEPTH = 2

HEAD_DIM = 128
N_HEADS = D_MODEL // HEAD_DIM
H_DIFF = N_HEADS // 4
H_FOX = (N_HEADS - H_DIFF) // 2
H_DIL = N_HEADS - H_FOX - H_DIFF
DIFF_QK_DIM = HEAD_DIM // 2
DIFF_V_DIM = HEAD_DIM
DIL_PATTERNS = ((128, 1), (512, 4), (2048, 16))
Q_BLOCK = 128
NUM_BUCKETS = 32
MAX_DISTANCE = 2048
D_FF = 4 * D_MODEL
N_MOD = 6
RMS_EPS = 1e-6

FOX_QKV = 3 * H_FOX * HEAD_DIM
DIL_QKV = 3 * H_DIL * HEAD_DIM
DIFF_QK = 4 * H_DIFF * DIFF_QK_DIM
DIFF_V = H_DIFF * DIFF_V_DIM
P_IN = FOX_QKV + H_FOX + DIL_QKV + DIFF_QK + DIFF_V
SPLIT_IDX = [FOX_QKV, FOX_QKV + H_FOX, FOX_QKV + H_FOX + DIL_QKV, FOX_QKV + H_FOX + DIL_QKV + DIFF_QK]

kernel_name = "hybrid_fox_dilated_diff_adaln"


def rmsnorm(x, g):
    x32 = x.astype(jnp.float32)
    y = x32 * lax.rsqrt(jnp.mean(x32 * x32, axis=-1, keepdims=True) + RMS_EPS)
    return (y * g.astype(jnp.float32)).astype(x.dtype)


def t5_bucket(dist):
    max_exact = NUM_BUCKETS // 2
    n = jnp.maximum(dist, 0)
    nf = jnp.maximum(n, 1).astype(jnp.float32)
    large = max_exact + (jnp.log(nf / max_exact) / math.log(MAX_DISTANCE / max_exact)
                         * (NUM_BUCKETS - max_exact)).astype(jnp.int32)
    large = jnp.minimum(large, NUM_BUCKETS - 1)
    return jnp.where(n < max_exact, n, large)


def to_heads(a, h):
    b, s, _ = a.shape
    return a.reshape(b, s, h, -1).transpose(0, 2, 1, 3)


def from_heads(a):
    b, h, s, dh = a.shape
    return a.transpose(0, 2, 1, 3).reshape(b, s, h * dh)


def fox_attention(q, k, v, log_f):
    B, H, S, dh = q.shape
    nb = S // Q_BLOCK
    scale = dh ** -0.5
    F = jnp.cumsum(log_f.astype(jnp.float32), axis=-1)
    qb = q.reshape(B, H, nb, Q_BLOCK, dh).transpose(2, 0, 1, 3, 4)
    Fb = F.reshape(B, H, nb, Q_BLOCK).transpose(2, 0, 1, 3)
    kpos = jnp.arange(S)

    def block(args):
        q_i, F_i, i = args
        qpos = i * Q_BLOCK + jnp.arange(Q_BLOCK)
        s = jnp.einsum('bhqd,bhkd->bhqk', q_i, k).astype(jnp.float32) * scale
        s = s + (F_i[..., :, None] - F[..., None, :])
        s = jnp.where(kpos[None, :] <= qpos[:, None], s, -jnp.inf)
        p = jax.nn.softmax(s, axis=-1)
        return jnp.einsum('bhqk,bhkd->bhqd', p.astype(v.dtype), v)

    o = lax.map(block, (qb, Fb, jnp.arange(nb)))
    return o.transpose(1, 2, 0, 3, 4).reshape(B, H, S, dh)


def dilated_branch(q, k, v, rel_table, window, dilation):
    B, H, S, dh = q.shape
    d = dilation
    blk = window // d
    L = S // d
    nb = -(-L // blk)
    Lp = nb * blk
    scale = dh ** -0.5

    def regroup(a):
        return a.reshape(B, H, L, d, dh).transpose(0, 1, 3, 2, 4)

    qs = jnp.pad(regroup(q), ((0, 0), (0, 0), (0, 0), (0, Lp - L), (0, 0))).reshape(B, H, d, nb, blk, dh)

    def windows(a):
        ap = jnp.pad(regroup(a), ((0, 0), (0, 0), (0, 0), (blk, Lp - L), (0, 0))).reshape(B, H, d, nb + 1, blk, dh)
        return jnp.concatenate([ap[:, :, :, :-1], ap[:, :, :, 1:]], axis=-2)

    kw, vw = windows(k), windows(v)
    qi = jnp.arange(blk)[:, None]
    ki = jnp.arange(2 * blk)[None, :]
    dist = blk + qi - ki
    key_idx = (jnp.arange(nb) * blk - blk)[:, None, None] + ki[None]
    valid = (dist >= 0) & (dist <= blk) & (key_idx >= 0)
    bias = rel_table[t5_bucket(dist * d)].transpose(2, 0, 1).astype(jnp.float32)
    s = jnp.einsum('bhrnqe,bhrnke->bhrnqk', qs, kw).astype(jnp.float32) * scale
    s = s + bias[None, :, None, None]
    s = jnp.where(valid, s, -jnp.inf)
    m = jnp.max(s, axis=-1, keepdims=True)
    e = jnp.exp(s - m)
    den = jnp.sum(e, axis=-1)
    o = jnp.einsum('bhrnqk,bhrnke->bhrnqe', (e / den[..., None]).astype(v.dtype), vw)
    lse = m[..., 0] + jnp.log(den)
    o = o.reshape(B, H, d, Lp, dh)[:, :, :, :L].transpose(0, 1, 3, 2, 4).reshape(B, H, S, dh)
    lse = lse.reshape(B, H, d, Lp)[..., :L].transpose(0, 1, 3, 2).reshape(B, H, S)
    return o, lse


def dilated_attention(q, k, v, rel_table):
    outs, lses = [], []
    for window, dilation in DIL_PATTERNS:
        o, lse = dilated_branch(q, k, v, rel_table, window, dilation)
        outs.append(o)
        lses.append(lse)
    w = jax.nn.softmax(jnp.stack(lses), axis=0)
    return jnp.einsum('pbhs,pbhsd->bhsd', w.astype(q.dtype), jnp.stack(outs))


def diff_attention(q, k, v, lam, rel_table):
    B, H, _, S, dqk = q.shape
    dv = v.shape[-1]
    nb = S // Q_BLOCK
    scale = dqk ** -0.5
    qb = q.reshape(B, H, 2, nb, Q_BLOCK, dqk).transpose(3, 0, 1, 2, 4, 5)
    kpos = jnp.arange(S)

    def block(args):
        q_i, i = args
        qpos = i * Q_BLOCK + jnp.arange(Q_BLOCK)
        dist = qpos[:, None] - kpos[None, :]
        bias = rel_table[t5_bucket(dist)].transpose(2, 0, 1).astype(jnp.float32)
        s = jnp.einsum('bhmqd,bhmkd->bhmqk', q_i, k).astype(jnp.float32) * scale
        s = s + bias[None, :, None]
        s = jnp.where(dist >= 0, s, -jnp.inf)
        p = jax.nn.softmax(s, axis=-1)
        a = p[:, :, 0] - lam * p[:, :, 1]
        return jnp.einsum('bhqk,bhkd->bhqd', a.astype(v.dtype), v)

    o = lax.map(block, (qb, jnp.arange(nb)))
    return o.transpose(1, 2, 0, 3, 4).reshape(B, H, S, dv)


def hybrid_mixer(h, w_in, b_forget, lam_q1, lam_k1, lam_q2, lam_k2, subln_g, w_out, rel_table, layer_idx):
    B, S, _ = h.shape
    proj = h @ w_in
    fox_qkv, f_logit, dil_qkv, diff_qk, diff_v = jnp.split(proj, SPLIT_IDX, axis=-1)

    qa, ka, va = [to_heads(t, H_FOX) for t in jnp.split(fox_qkv, 3, axis=-1)]
    log_f = jax.nn.log_sigmoid((f_logit + b_forget).astype(jnp.float32)).transpose(0, 2, 1)
    o_a = fox_attention(qa, ka, va, log_f)

    qb, kb, vb = [to_heads(t, H_DIL) for t in jnp.split(dil_qkv, 3, axis=-1)]
    o_b = dilated_attention(qb, kb, vb, rel_table[:, :H_DIL])

    qc, kc = [t.reshape(B, S, H_DIFF, 2, DIFF_QK_DIM).transpose(0, 2, 3, 1, 4)
              for t in jnp.split(diff_qk, 2, axis=-1)]
    vc = to_heads(diff_v, H_DIFF)
    lam_init = 0.8 - 0.6 * math.exp(-0.3 * layer_idx)
    lam = (jnp.exp(jnp.sum(lam_q1.astype(jnp.float32) * lam_k1.astype(jnp.float32)))
           - jnp.exp(jnp.sum(lam_q2.astype(jnp.float32) * lam_k2.astype(jnp.float32))) + lam_init)
    o_c = diff_attention(qc, kc, vc, lam, rel_table[:, H_DIL:])
    o_c = rmsnorm(o_c, subln_g) * (1.0 - lam_init)

    y = jnp.concatenate([from_heads(o_a), from_heads(o_b), from_heads(o_c)], axis=-1)
    return y @ w_out


def squared_relu_mlp(h, w1, w2):
    return jnp.square(jax.nn.relu(h @ w1)) @ w2


def setup_inputs(seed: int = 0) -> dict:
    key = jax.random.key(seed)
    ks = jax.random.split(key, 18)
    f32 = jnp.float32
    nrm = lambda k, shape, s: jax.random.normal(k, shape, f32) * s
    return {
        "x": nrm(ks[0], (BATCH, SEQ, D_MODEL), 1.0),
        "c": nrm(ks[1], (BATCH, D_MODEL), 1.0),
        "w_ada": nrm(ks[2], (DEPTH, D_MODEL, N_MOD * D_MODEL), 0.5 * D_MODEL ** -0.5),
        "b_ada": nrm(ks[3], (DEPTH, N_MOD * D_MODEL), 0.02),
        "norm1_g": 1.0 + nrm(ks[4], (DEPTH, D_MODEL), 0.05),
        "w_in": nrm(ks[5], (DEPTH, D_MODEL, P_IN), D_MODEL ** -0.5),
        "b_forget": 2.0 + nrm(ks[6], (DEPTH, H_FOX), 0.5),
        "lambda_q1": nrm(ks[7], (DEPTH, DIFF_QK_DIM), 0.1),
        "lambda_k1": nrm(ks[8], (DEPTH, DIFF_QK_DIM), 0.1),
        "lambda_q2": nrm(ks[9], (DEPTH, DIFF_QK_DIM), 0.1),
        "lambda_k2": nrm(ks[10], (DEPTH, DIFF_QK_DIM), 0.1),
        "diff_subln_g": 1.0 + nrm(ks[11], (DEPTH, DIFF_V_DIM), 0.05),
        "w_out": nrm(ks[12], (DEPTH, D_MODEL, D_MODEL), D_MODEL ** -0.5),
        "norm2_g": 1.0 + nrm(ks[13], (DEPTH, D_MODEL), 0.05),
        "w_mlp1": nrm(ks[14], (DEPTH, D_MODEL, D_FF), D_MODEL ** -0.5),
        "w_mlp2": nrm(ks[15], (DEPTH, D_FF, D_MODEL), D_FF ** -0.5),
        "rel_table": nrm(ks[16], (NUM_BUCKETS, H_DIL + H_DIFF), 0.5),
        "final_norm_g": 1.0 + nrm(ks[17], (D_MODEL,), 0.05),
    }


def reference(x, c, w_ada, b_ada, norm1_g, w_in, b_forget, lambda_q1, lambda_k1, lambda_q2, lambda_k2,
              diff_subln_g, w_out, norm2_g, w_mlp1, w_mlp2, rel_table, final_norm_g):
    for l in range(DEPTH):
        mod = c @ w_ada[l] + b_ada[l]
        sh1, sc1, g1, sh2, sc2, g2 = [m[:, None, :] for m in jnp.split(mod, N_MOD, axis=-1)]
        h = rmsnorm(x, norm1_g[l]) * (1.0 + sc1) + sh1
        x = x + g1 * hybrid_mixer(h, w_in[l], b_forget[l], lambda_q1[l], lambda_k1[l], lambda_q2[l],
                                  lambda_k2[l], diff_subln_g[l], w_out[l], rel_table, l)
        h = rmsnorm(x, norm2_g[l]) * (1.0 + sc2) + sh2
        x = x + g2 * squared_relu_mlp(h, w_mlp1[l], w_mlp2[l])
    return rmsnorm(x, final_norm_g)
```

```cpp
#include <hip/hip_runtime.h>
#include <cstdio>
#include <cstdint>

typedef unsigned short bf16;
typedef short bf16x8 __attribute__((ext_vector_type(8)));
typedef float f32x4 __attribute__((ext_vector_type(4)));
typedef unsigned u32x4 __attribute__((ext_vector_type(4)));

constexpr int DM = 2048, NBATCH = 2, SEQ = 4096, MTOK = 8192, DEPTH = 2, HD = 128;
constexpr int PIN = 6150, NPROJ = 6144, DFF = 8192, NMOD = 12288;
constexpr int C_FQ = 0, C_FK = 768, C_FV = 1536, C_DQ = 2304, C_DK = 3072, C_DV = 3840, C_XQ = 4608, C_XK = 5120, C_XV = 5632;
constexpr size_t MiB = 1u << 20;
constexpr size_t WS_MOD = 1 * MiB, WS_WF = WS_MOD + 256 * 1024, WS_LOGF = WS_WF + 256 * 1024, WS_FCUM = WS_LOGF + 256 * 1024, WS_LSE = 2 * MiB;
constexpr size_t WS_WTIN = 4 * MiB, WS_WTOUT = 52 * MiB, WS_WT1 = 68 * MiB, WS_WT2 = 132 * MiB;
constexpr size_t WS_H = 196 * MiB, WS_XA = 228 * MiB, WS_PROJ = 292 * MiB, WS_Y = 388 * MiB, WS_U = 292 * MiB;
constexpr size_t WS_ODIL = 420 * MiB, WS_ODIFF = 456 * MiB, WS_SBUF = 472 * MiB, WS_PBUF = 536 * MiB, WS_VT = 568 * MiB, WS_END = 569 * MiB;

__device__ __forceinline__ unsigned f2bf(float f) { unsigned u = __builtin_bit_cast(unsigned, f); return (u + 0x7fffu + ((u >> 16) & 1u)) >> 16; }
__device__ __forceinline__ float bf2f(bf16 v) { return __builtin_bit_cast(float, (unsigned)v << 16); }
__device__ __forceinline__ float wave_sum(float v) {
#pragma unroll
    for (int o = 1; o < 64; o <<= 1) v += __shfl_xor(v, o);
    return v;
}
__device__ __forceinline__ float wave_max(float v) {
#pragma unroll
    for (int o = 1; o < 64; o <<= 1) v = fmaxf(v, __shfl_xor(v, o));
    return v;
}
__device__ __forceinline__ int t5_bucket(int n) {
    if (n < 16) return n;
    return 16 + (n >= 22) + (n >= 30) + (n >= 40) + (n >= 54) + (n >= 73) + (n >= 99) + (n >= 134) + (n >= 182) + (n >= 246) + (n >= 332) + (n >= 450) + (n >= 609) +
           (n >= 825) + (n >= 1117) + (n >= 1513);
}
__device__ __forceinline__ float lam_init_of(int l) { return 0.8f - 0.6f * expf(-0.3f * (float)l); }
__device__ __forceinline__ float lam_of(const float* q1, const float* k1, const float* q2, const float* k2, int l, int lane) {
    const float a = wave_sum(q1[l * 64 + lane] * k1[l * 64 + lane]), b = wave_sum(q2[l * 64 + lane] * k2[l * 64 + lane]);
    return expf(a) - expf(b) + lam_init_of(l);
}

__global__ void k_wT(const float* __restrict__ W, int K, int Nsrc, bf16* __restrict__ WT, int skip_at, int skip_n) {
    __shared__ float t[32][33];
    const int n0 = blockIdx.x * 32, k0 = blockIdx.y * 32;
    for (int i = threadIdx.y; i < 32; i += 8) { const int n = n0 + threadIdx.x; const int sc = n + (n >= skip_at ? skip_n : 0); t[i][threadIdx.x] = W[(size_t)(k0 + i) * Nsrc + sc]; }
    __syncthreads();
    for (int i = threadIdx.y; i < 32; i += 8) WT[(size_t)(n0 + i) * K + k0 + threadIdx.x] = (bf16)f2bf(t[threadIdx.x][i]);
}
__global__ void k_wf(const float* __restrict__ w_in, float* __restrict__ WF) {
    const int idx = blockIdx.x * 256 + threadIdx.x; if (idx >= DEPTH * 6 * DM) return;
    const int l = idx / (6 * DM), r = idx % (6 * DM), j = r / DM, k = r % DM;
    WF[idx] = w_in[((size_t)l * DM + k) * PIN + 2304 + j];
}
__global__ void k_ada(const float* __restrict__ c, const float* __restrict__ w_ada, const float* __restrict__ b_ada, float* __restrict__ mod) {
    const int idx = blockIdx.x * 256 + threadIdx.x; const int l = idx / NMOD, j = idx % NMOD;
    const float* w = w_ada + (size_t)l * DM * NMOD + j; float a0 = 0.f, a1 = 0.f;
    for (int k = 0; k < DM; ++k) { const float wv = w[(size_t)k * NMOD]; a0 += c[k] * wv; a1 += c[DM + k] * wv; }
    mod[(l * 2 + 0) * NMOD + j] = a0 + b_ada[l * NMOD + j]; mod[(l * 2 + 1) * NMOD + j] = a1 + b_ada[l * NMOD + j];
}
__global__ __launch_bounds__(256) void k_norm(const float* __restrict__ x, const float* __restrict__ g, const float* __restrict__ sc, const float* __restrict__ sh,
                                               bf16* __restrict__ outb, float* __restrict__ outf, const float* __restrict__ WF, const float* __restrict__ b_forget, float* __restrict__ logf) {
    const int lane = threadIdx.x & 63, row = blockIdx.x * 4 + (threadIdx.x >> 6), b = row / SEQ, s = row % SEQ;
    const float* xr = x + (size_t)row * DM; f32x4 v[8]; float ss = 0.f;
#pragma unroll
    for (int i = 0; i < 8; ++i) { v[i] = *(const f32x4*)(xr + i * 256 + lane * 4); ss += v[i][0] * v[i][0] + v[i][1] * v[i][1] + v[i][2] * v[i][2] + v[i][3] * v[i][3]; }
    const float rstd = rsqrtf(wave_sum(ss) * (1.f / DM) + 1e-6f);
    float dots[6] = {0.f, 0.f, 0.f, 0.f, 0.f, 0.f};
#pragma unroll
    for (int i = 0; i < 8; ++i) { const int col = i * 256 + lane * 4; const f32x4 gv = *(const f32x4*)(g + col); f32x4 y = v[i] * rstd * gv;
        if (sc) { const f32x4 s1 = *(const f32x4*)(sc + (size_t)b * NMOD + col), s0 = *(const f32x4*)(sh + (size_t)b * NMOD + col); y = y * (1.f + s1) + s0; }
        if (outf) *(f32x4*)(outf + (size_t)row * DM + col) = y;
        if (outb) { unsigned lo = f2bf(y[0]) | (f2bf(y[1]) << 16), hi = f2bf(y[2]) | (f2bf(y[3]) << 16); *(uint2*)(outb + (size_t)row * DM + col) = make_uint2(lo, hi); }
        if (WF) {
#pragma unroll
            for (int j = 0; j < 6; ++j) { const f32x4 wv = *(const f32x4*)(WF + j * DM + col); dots[j] += y[0] * wv[0] + y[1] * wv[1] + y[2] * wv[2] + y[3] * wv[3]; } }
    }
    if (WF) {
#pragma unroll
        for (int j = 0; j < 6; ++j) { const float z = wave_sum(dots[j]) + b_forget[j]; const float ls = fminf(z, 0.f) - log1pf(expf(-fabsf(z)));
            if (lane == 0) logf[((size_t)b * 6 + j) * SEQ + s] = ls; }
    }
}
__global__ __launch_bounds__(256) void k_cumsum(const float* __restrict__ logf, float* __restrict__ F) {
    __shared__ float tot[256];
    const int tid = threadIdx.x; const float* in = logf + (size_t)blockIdx.x * SEQ + tid * 16; float v[16]; float run = 0.f;
#pragma unroll
    for (int i = 0; i < 16; ++i) { run += in[i]; v[i] = run; }
    tot[tid] = run; __syncthreads();
    if (tid == 0) { float a = 0.f; for (int i = 0; i < 256; ++i) { const float t = tot[i]; tot[i] = a; a += t; } }
    __syncthreads();
    const float off = tot[tid]; float* o = F + (size_t)blockIdx.x * SEQ + tid * 16;
#pragma unroll
    for (int i = 0; i < 16; ++i) o[i] = v[i] + off;
}
template <int EPI>
__global__ __launch_bounds__(256) void k_gemm(const bf16* __restrict__ A, int lda, const bf16* __restrict__ Bt, int ldb, int K, void* Cv, int ldc,
                                               const float* base, const float* __restrict__ gate) {
    __shared__ __attribute__((aligned(16))) bf16 sA[128 * 40];
    __shared__ __attribute__((aligned(16))) bf16 sB[128 * 40];
    const int tid = threadIdx.x, lane = tid & 63, w = tid >> 6, wr = w >> 1, wc = w & 1;
    const int m0 = blockIdx.y * 128, n0 = blockIdx.x * 128;
    f32x4 acc[4][4];
#pragma unroll
    for (int i = 0; i < 4; ++i)
#pragma unroll
        for (int j = 0; j < 4; ++j) acc[i][j] = (f32x4){0.f, 0.f, 0.f, 0.f};
    for (int k0 = 0; k0 < K; k0 += 32) {
#pragma unroll
        for (int i = 0; i < 2; ++i) { const int c = tid + i * 256, row = c >> 2, kc = (c & 3) * 8;
            *(u32x4*)&sA[row * 40 + kc] = *(const u32x4*)&A[(size_t)(m0 + row) * lda + k0 + kc];
            *(u32x4*)&sB[row * 40 + kc] = *(const u32x4*)&Bt[(size_t)(n0 + row) * ldb + k0 + kc]; }
        __syncthreads();
        bf16x8 a[4], b[4];
#pragma unroll
        for (int i = 0; i < 4; ++i) { a[i] = *(const bf16x8*)&sA[(wr * 64 + i * 16 + (lane & 15)) * 40 + (lane >> 4) * 8]; b[i] = *(const bf16x8*)&sB[(wc * 64 + i * 16 + (lane & 15)) * 40 + (lane >> 4) * 8]; }
#pragma unroll
        for (int i = 0; i < 4; ++i)
#pragma unroll
            for (int j = 0; j < 4; ++j) acc[i][j] = __builtin_amdgcn_mfma_f32_16x16x32_bf16(a[i], b[j], acc[i][j], 0, 0, 0);
        __syncthreads();
    }
#pragma unroll
    for (int i = 0; i < 4; ++i)
#pragma unroll
        for (int j = 0; j < 4; ++j)
#pragma unroll
            for (int r = 0; r < 4; ++r) { const int row = m0 + wr * 64 + i * 16 + (lane >> 4) * 4 + r, col = n0 + wc * 64 + j * 16 + (lane & 15); const float v = acc[i][j][r];
                const size_t o = (size_t)row * ldc + col;
                if (EPI == 0) ((float*)Cv)[o] = v;
                else if (EPI == 1) ((bf16*)Cv)[o] = (bf16)f2bf(v);
                else if (EPI == 2) { const float rl = fmaxf(v, 0.f); ((bf16*)Cv)[o] = (bf16)f2bf(rl * rl); }
                else ((float*)Cv)[o] = base[o] + gate[(size_t)(row / SEQ) * NMOD + col] * v; }
}
__global__ void k_vT(const bf16* __restrict__ V, int ldv, bf16* __restrict__ VT) {
    __shared__ bf16 t[32][33];
    const int s0 = blockIdx.x * 32, d0 = blockIdx.y * 32;
    for (int i = threadIdx.y; i < 32; i += 8) t[i][threadIdx.x] = V[(size_t)(s0 + i) * ldv + d0 + threadIdx.x];
    __syncthreads();
    for (int i = threadIdx.y; i < 32; i += 8) VT[(size_t)(d0 + i) * SEQ + s0 + threadIdx.x] = t[threadIdx.x][i];
}
template <int MODE>
__global__ __launch_bounds__(256) void k_softmax(const float* __restrict__ S, bf16* __restrict__ P, float scale, const float* __restrict__ F, const float* __restrict__ relh, int dil, float* __restrict__ lse) {
    __shared__ float red[8];
    const int t = blockIdx.x, tid = threadIdx.x, lane = tid & 63, w = tid >> 6;
    float lg[16]; float m = -1e30f;
#pragma unroll
    for (int i = 0; i < 16; ++i) { const int s = tid + 256 * i; const int dl = t - s; bool valid; float bias;
        if (MODE == 0) { valid = dl >= 0; bias = valid ? F[t] - F[s] : 0.f; }
        else if (MODE == 1) { valid = dl >= 0 && (dl % dil) == 0 && (dl / dil) <= 128; bias = valid ? relh[t5_bucket(dl) * 10] : 0.f; }
        else { valid = dl >= 0; bias = valid ? relh[t5_bucket(dl) * 10] : 0.f; }
        lg[i] = valid ? S[(size_t)t * SEQ + s] * scale + bias : -__builtin_inff(); m = fmaxf(m, lg[i]); }
    m = wave_max(m); if (lane == 0) red[w] = m; __syncthreads(); m = fmaxf(fmaxf(red[0], red[1]), fmaxf(red[2], red[3])); __syncthreads();
    float sum = 0.f;
#pragma unroll
    for (int i = 0; i < 16; ++i) { lg[i] = expf(lg[i] - m); sum += lg[i]; }
    sum = wave_sum(sum); if (lane == 0) red[w] = sum; __syncthreads(); sum = (red[0] + red[1]) + (red[2] + red[3]);
    const float inv = 1.f / sum;
#pragma unroll
    for (int i = 0; i < 16; ++i) P[(size_t)t * SEQ + tid + 256 * i] = (bf16)f2bf(lg[i] * inv);
    if (lse && tid == 0) lse[t] = m + logf(sum);
}
__global__ __launch_bounds__(256) void k_dil_combine(const bf16* __restrict__ od, const float* __restrict__ lse, bf16* __restrict__ Y) {
    const int lane = threadIdx.x & 63, wv = blockIdx.x * 4 + (threadIdx.x >> 6), row = wv / 6, h = wv % 6, b = row / SEQ, s = row % SEQ;
    float l[3]; for (int p = 0; p < 3; ++p) l[p] = lse[((size_t)p * 12 + b * 6 + h) * SEQ + s];
    const float mx = fmaxf(l[0], fmaxf(l[1], l[2])); float e[3], sum = 0.f; for (int p = 0; p < 3; ++p) { e[p] = expf(l[p] - mx); sum += e[p]; }
    float a0 = 0.f, a1 = 0.f;
    for (int p = 0; p < 3; ++p) { const unsigned u = *(const unsigned*)(od + ((size_t)p * MTOK + row) * 768 + h * 128 + lane * 2); const float wgt = e[p] / sum;
        a0 += wgt * bf2f((bf16)(u & 0xffff)); a1 += wgt * bf2f((bf16)(u >> 16)); }
    *(unsigned*)(Y + (size_t)row * DM + 768 + h * 128 + lane * 2) = f2bf(a0) | (f2bf(a1) << 16);
}
__global__ __launch_bounds__(256) void k_diff_combine(const bf16* __restrict__ ox, const float* __restrict__ lq1, const float* __restrict__ lk1, const float* __restrict__ lq2, const float* __restrict__ lk2,
                                                       const float* __restrict__ subg, int l, bf16* __restrict__ Y) {
    const int lane = threadIdx.x & 63, wv = blockIdx.x * 4 + (threadIdx.x >> 6), row = wv / 4, h = wv % 4;
    const float lam = lam_of(lq1, lk1, lq2, lk2, l, lane);
    const unsigned u1 = *(const unsigned*)(ox + (size_t)row * 512 + h * 128 + lane * 2), u2 = *(const unsigned*)(ox + ((size_t)MTOK + row) * 512 + h * 128 + lane * 2);
    const float a0 = bf2f((bf16)(u1 & 0xffff)) - lam * bf2f((bf16)(u2 & 0xffff)), a1 = bf2f((bf16)(u1 >> 16)) - lam * bf2f((bf16)(u2 >> 16));
    const float rstd = rsqrtf(wave_sum(a0 * a0 + a1 * a1) * (1.f / 128.f) + 1e-6f), k = 1.f - lam_init_of(l);
    const float y0 = a0 * rstd * subg[l * 128 + lane * 2] * k, y1 = a1 * rstd * subg[l * 128 + lane * 2 + 1] * k;
    *(unsigned*)(Y + (size_t)row * DM + 1536 + h * 128 + lane * 2) = f2bf(y0) | (f2bf(y1) << 16);
}

extern "C" void kernel_launch(void* const* d_in, const int* in_sizes, int n_in, void* d_out, int out_size, void* d_ws, size_t ws_size, hipStream_t stream) {
    if (n_in != 18 || in_sizes[0] != MTOK * DM || out_size != MTOK * DM || ws_size < WS_END) { fprintf(stderr, "kernel_launch: unexpected shapes / workspace (%d %d %zu)\n", n_in, out_size, ws_size); return; }
    const float* x = (const float*)d_in[0]; const float* c = (const float*)d_in[1]; const float* w_ada = (const float*)d_in[2]; const float* b_ada = (const float*)d_in[3];
    const float* norm1_g = (const float*)d_in[4]; const float* w_in = (const float*)d_in[5]; const float* b_forget = (const float*)d_in[6];
    const float* lq1 = (const float*)d_in[7]; const float* lk1 = (const float*)d_in[8]; const float* lq2 = (const float*)d_in[9]; const float* lk2 = (const float*)d_in[10];
    const float* subg = (const float*)d_in[11]; const float* w_out = (const float*)d_in[12]; const float* norm2_g = (const float*)d_in[13];
    const float* w1 = (const float*)d_in[14]; const float* w2 = (const float*)d_in[15]; const float* rel = (const float*)d_in[16]; const float* fin_g = (const float*)d_in[17];
    char* ws = (char*)d_ws;
    float* MOD = (float*)(ws + WS_MOD); float* WF = (float*)(ws + WS_WF); float* LOGF = (float*)(ws + WS_LOGF); float* FC = (float*)(ws + WS_FCUM); float* LSE = (float*)(ws + WS_LSE);
    bf16* WTIN = (bf16*)(ws + WS_WTIN); bf16* WTOUT = (bf16*)(ws + WS_WTOUT); bf16* WT1 = (bf16*)(ws + WS_WT1); bf16* WT2 = (bf16*)(ws + WS_WT2);
    bf16* Hb = (bf16*)(ws + WS_H); float* XA = (float*)(ws + WS_XA); bf16* PROJ = (bf16*)(ws + WS_PROJ); bf16* Y = (bf16*)(ws + WS_Y); bf16* U = (bf16*)(ws + WS_U);
    bf16* ODIL = (bf16*)(ws + WS_ODIL); bf16* ODIFF = (bf16*)(ws + WS_ODIFF); float* SB = (float*)(ws + WS_SBUF); bf16* PB = (bf16*)(ws + WS_PBUF); bf16* VT = (bf16*)(ws + WS_VT);
    const dim3 tb(32, 8);
    for (int l = 0; l < DEPTH; ++l) {
        k_wT<<<dim3(NPROJ / 32, DM / 32), tb, 0, stream>>>(w_in + (size_t)l * DM * PIN, DM, PIN, WTIN + (size_t)l * NPROJ * DM, 2304, 6);
        k_wT<<<dim3(DM / 32, DM / 32), tb, 0, stream>>>(w_out + (size_t)l * DM * DM, DM, DM, WTOUT + (size_t)l * DM * DM, 1 << 30, 0);
        k_wT<<<dim3(DFF / 32, DM / 32), tb, 0, stream>>>(w1 + (size_t)l * DM * DFF, DM, DFF, WT1 + (size_t)l * DFF * DM, 1 << 30, 0);
        k_wT<<<dim3(DM / 32, DFF / 32), tb, 0, stream>>>(w2 + (size_t)l * DFF * DM, DFF, DM, WT2 + (size_t)l * DM * DFF, 1 << 30, 0);
    }
    k_wf<<<(DEPTH * 6 * DM + 255) / 256, 256, 0, stream>>>(w_in, WF);
    k_ada<<<DEPTH * NMOD / 256, 256, 0, stream>>>(c, w_ada, b_ada, MOD);
    const float* xcur = x;
    for (int l = 0; l < DEPTH; ++l) {
        const float* mod = MOD + (size_t)l * 2 * NMOD;
        k_norm<<<MTOK / 4, 256, 0, stream>>>(xcur, norm1_g + l * DM, mod + 1 * DM, mod + 0 * DM, Hb, nullptr, WF + (size_t)l * 6 * DM, b_forget + l * 6, LOGF);
        k_cumsum<<<12, 256, 0, stream>>>(LOGF, FC);
        k_gemm<1><<<dim3(NPROJ / 128, MTOK / 128), 256, 0, stream>>>(Hb, DM, WTIN + (size_t)l * NPROJ * DM, DM, DM, PROJ, NPROJ, nullptr, nullptr);
        for (int b = 0; b < NBATCH; ++b) {
            const bf16* pb = PROJ + (size_t)b * SEQ * NPROJ;
            for (int h = 0; h < 6; ++h) {
                k_gemm<0><<<dim3(SEQ / 128, SEQ / 128), 256, 0, stream>>>(pb + C_FQ + h * 128, NPROJ, pb + C_FK + h * 128, NPROJ, 128, SB, SEQ, nullptr, nullptr);
                k_vT<<<dim3(SEQ / 32, 4), tb, 0, stream>>>(pb + C_FV + h * 128, NPROJ, VT);
                k_softmax<0><<<SEQ, 256, 0, stream>>>(SB, PB, 0.08838834764831845f, FC + (size_t)(b * 6 + h) * SEQ, nullptr, 1, nullptr);
                k_gemm<1><<<dim3(1, SEQ / 128), 256, 0, stream>>>(PB, SEQ, VT, SEQ, SEQ, Y + (size_t)b * SEQ * DM + h * 128, DM, nullptr, nullptr);
            }
            for (int h = 0; h < 6; ++h) {
                k_gemm<0><<<dim3(SEQ / 128, SEQ / 128), 256, 0, stream>>>(pb + C_DQ + h * 128, NPROJ, pb + C_DK + h * 128, NPROJ, 128, SB, SEQ, nullptr, nullptr);
                k_vT<<<dim3(SEQ / 32, 4), tb, 0, stream>>>(pb + C_DV + h * 128, NPROJ, VT);
                for (int p = 0; p < 3; ++p) { const int dil = p == 0 ? 1 : (p == 1 ? 4 : 16);
                    k_softmax<1><<<SEQ, 256, 0, stream>>>(SB, PB, 0.08838834764831845f, nullptr, rel + h, dil, LSE + ((size_t)p * 12 + b * 6 + h) * SEQ);
                    k_gemm<1><<<dim3(1, SEQ / 128), 256, 0, stream>>>(PB, SEQ, VT, SEQ, SEQ, ODIL + ((size_t)p * MTOK + (size_t)b * SEQ) * 768 + h * 128, 768, nullptr, nullptr); }
            }
            for (int h = 0; h < 4; ++h) {
                k_vT<<<dim3(SEQ / 32, 4), tb, 0, stream>>>(pb + C_XV + h * 128, NPROJ, VT);
                for (int m = 0; m < 2; ++m) {
                    k_gemm<0><<<dim3(SEQ / 128, SEQ / 128), 256, 0, stream>>>(pb + C_XQ + h * 128 + m * 64, NPROJ, pb + C_XK + h * 128 + m * 64, NPROJ, 64, SB, SEQ, nullptr, nullptr);
                    k_softmax<2><<<SEQ, 256, 0, stream>>>(SB, PB, 0.125f, nullptr, rel + 6 + h, 1, nullptr);
                    k_gemm<1><<<dim3(1, SEQ / 128), 256, 0, stream>>>(PB, SEQ, VT, SEQ, SEQ, ODIFF + ((size_t)m * MTOK + (size_t)b * SEQ) * 512 + h * 128, 512, nullptr, nullptr); }
            }
        }
        k_dil_combine<<<MTOK * 6 / 4, 256, 0, stream>>>(ODIL, LSE, Y);
        k_diff_combine<<<MTOK * 4 / 4, 256, 0, stream>>>(ODIFF, lq1, lk1, lq2, lk2, subg, l, Y);
        k_gemm<3><<<dim3(DM / 128, MTOK / 128), 256, 0, stream>>>(Y, DM, WTOUT + (size_t)l * DM * DM, DM, DM, XA, DM, xcur, mod + 2 * DM);
        k_norm<<<MTOK / 4, 256, 0, stream>>>(XA, norm2_g + l * DM, mod + 4 * DM, mod + 3 * DM, Hb, nullptr, nullptr, nullptr, nullptr);
        k_gemm<2><<<dim3(DFF / 128, MTOK / 128), 256, 0, stream>>>(Hb, DM, WT1 + (size_t)l * DFF * DM, DM, DM, U, DFF, nullptr, nullptr);
        k_gemm<3><<<dim3(DM / 128, MTOK / 128), 256, 0, stream>>>(U, DFF, WT2 + (size_t)l * DM * DFF, DFF, DFF, XA, DM, XA, mod + 5 * DM);
        xcur = XA;
    }
    k_norm<<<MTOK / 4, 256, 0, stream>>>(XA, fin_g, nullptr, nullptr, nullptr, (float*)d_out, nullptr, nullptr, nullptr);
}
```

```cpp
#include <hip/hip_runtime.h>
#include <cstdio>
#include <cstdint>
#ifndef ATTN_MEGA_KINDS
#define ATTN_MEGA_KINDS 7
#endif
#define ATTN_IN_MEGA (ATTN_MEGA_KINDS != 0)
namespace pg8 {
#define PG8_LAS __attribute__((address_space(3)))
typedef unsigned short bf16_t;
typedef short bf16x8 __attribute__((ext_vector_type(8)));
typedef float f32x4 __attribute__((ext_vector_type(4)));
typedef unsigned u32x4 __attribute__((ext_vector_type(4)));
constexpr int BM = 256, BK = 64, HALF = 128, HTB = HALF * BK * 2  , STAGE_BYTES = 8 * HTB, NXCD = 8, WGM = 8;

__host__ __device__ __forceinline__ int lds_byte(int r, int c) { const int st = (r >> 4) * 2 + (c >> 5), rr = r & 15, cc = c & 31, ob = rr * 64 + cc * 2; return st * 1024 + (ob ^ (((ob >> 9) & 1) << 5)); }
__host__ __device__ __forceinline__ void stage_rc(int b, int& R, int& C) { const int st = b / 1024, sb = b % 1024, swz = sb ^ (((sb >> 9) & 1) << 5); R = (st >> 1) * 16 + swz / 64; C = (st & 1) * 32 + (swz % 64) / 2; }
__host__ __device__ __forceinline__ int perm32(int rho) { const int n = rho >> 4, i = rho & 15; return 8 * (i >> 2) + 4 * n + (i & 3); }

struct Unit { int pm, pn; };
struct Gemm { const bf16_t* A; const bf16_t* Bt; int M, N, K; };

struct StaticOrder {
    int nM, nN, nwg, G, c;
    __host__ __device__ void init(int M, int N, int G_, int c_) { nM = M / BM; nN = N / BM; nwg = nM * nN; G = G_; c = c_; }
    __host__ __device__ bool next(int i, Unit& u) const {
        const long L = (long)i * G + c; if (L >= nwg) return false;
        int wgid = (int)L; { const int q = nwg / NXCD, r = nwg % NXCD, xcd = wgid % NXCD, off = wgid / NXCD; wgid = (xcd < r ? xcd * (q + 1) : r * (q + 1) + (xcd - r) * q) + off; }
        const int nig = WGM * nN, gid = wgid / nig, fm = gid * WGM, gsz = (nM - fm) < WGM ? (nM - fm) : WGM;
        u.pm = fm + ((wgid % nig) % gsz); u.pn = (wgid % nig) / gsz; return true;
    }
    __device__ __forceinline__ void a_ready(const Unit&) const {}
    __device__ __forceinline__ void done(const Unit&) const {}
};

__device__ __forceinline__ unsigned cvt_pk_bf16(float lo, float hi) { unsigned r; asm volatile("v_cvt_pk_bf16_f32 %0, %1, %2" : "=v"(r) : "v"(lo), "v"(hi)); return r; }
struct EpiBf16 {
    static constexpr bool PERM = true, AFTER_DRAIN = false;
    bf16_t* O; int ldc; int act;
    __device__ __forceinline__ void operator()(const f32x4 (&acc)[2][2][4][2], const Unit& u, int wr, int wc, int fr, int fq) const {
        const int row0 = u.pm * BM + wr * 64 + fr, col0 = u.pn * BM + wc * 32 + 8 * fq;
#pragma unroll
        for (int ai = 0; ai < 2; ++ai)
#pragma unroll
            for (int m = 0; m < 4; ++m) { bf16_t* rowp = O + (size_t)(row0 + ai * HALF + m * 16) * ldc + col0;
#pragma unroll
                for (int bj = 0; bj < 2; ++bj) { f32x4 v0 = acc[ai][bj][m][0], v1 = acc[ai][bj][m][1];
                    if (act) { const f32x4 z = {0.f, 0.f, 0.f, 0.f}; v0 = __builtin_elementwise_max(v0, z); v1 = __builtin_elementwise_max(v1, z); v0 = v0 * v0; v1 = v1 * v1; }
                    u32x4 w; w.x = cvt_pk_bf16(v0[0], v0[1]); w.y = cvt_pk_bf16(v0[2], v0[3]); w.z = cvt_pk_bf16(v1[0], v1[1]); w.w = cvt_pk_bf16(v1[2], v1[3]);
                    *(u32x4*)(rowp + bj * HALF) = w; } }
    }
};
struct EpiRes {
    static constexpr bool PERM = false, AFTER_DRAIN = false;
    const float* base; float* out; int ldc; const float* gate; int gate_bstride; int rows_per_batch;
    __device__ __forceinline__ void operator()(const f32x4 (&acc)[2][2][4][2], const Unit& u, int wr, int wc, int fr, int fq) const {
        const int col0 = u.pn * BM + wc * 32 + 4 * fq; const int b = (u.pm * BM) / rows_per_batch;
        f32x4 gv[2][2];
#pragma unroll
        for (int bj = 0; bj < 2; ++bj)
#pragma unroll
            for (int n = 0; n < 2; ++n) gv[bj][n] = *(const f32x4*)(gate + (size_t)b * gate_bstride + col0 + bj * HALF + n * 16);
#pragma unroll
        for (int ai = 0; ai < 2; ++ai)
#pragma unroll
            for (int m = 0; m < 4; ++m) { const size_t off = (size_t)(u.pm * BM + ai * HALF + wr * 64 + m * 16 + fr) * ldc + col0;
#pragma unroll
                for (int bj = 0; bj < 2; ++bj)
#pragma unroll
                    for (int n = 0; n < 2; ++n) { const f32x4 bs = *(const f32x4*)(base + off + bj * HALF + n * 16); *(f32x4*)(out + off + bj * HALF + n * 16) = bs + gv[bj][n] * acc[ai][bj][m][n]; }
                if (m & 1) asm volatile("" ::: "memory"); }
    }
};

template <class Epi, class Sched, bool ALIGN_EPI = false, bool SP2 = false>
__device__ __forceinline__ void gemm_phase(PG8_LAS unsigned char* lds, const Gemm g, const Sched& S, const Epi& E, const int tid) {
    const int wid = __builtin_amdgcn_readfirstlane(tid >> 6), lane = tid & 63, wr = wid >> 2, wc = wid & 3, fr = lane & 15, fq = lane >> 4;
    const int K = g.K, nt = K / BK;
    unsigned voffA[2], voffB[2];
#pragma unroll
    for (int i = 0; i < 2; ++i) { int R, C; stage_rc(tid * 16 + i * 8192, R, C); const int Rb = Epi::PERM ? ((R & ~31) + perm32(R & 31)) : R;
        voffA[i] = (unsigned)(R * K + C) * 2u; voffB[i] = (unsigned)(Rb * K + C) * 2u; }
    const size_t kstep = (size_t)(BK * 2);
    const size_t hstep = (size_t)HALF * K * 2;
    const size_t tstep = 2 * hstep;
    const unsigned ldsw = (unsigned)wid * 1024u;
    const int aoff = lds_byte(wr * 64 + fr, fq * 8), boff = lds_byte(wc * 32 + fr, fq * 8);
#define PG8_SA(b, h) (((b) * 2 + (h)) * HTB)
#define PG8_SB(b, h) ((4 + (b) * 2 + (h)) * HTB)
#define PG8_STAGE(bufoff, gbase, voff) do { _Pragma("unroll") for (int _i = 0; _i < 2; ++_i) \
        __builtin_amdgcn_global_load_lds((const unsigned*)((const char*)(gbase) + (voff)[_i]), (PG8_LAS unsigned*)(lds + (bufoff) + ldsw + _i * 8192), 16, 0, 0); } while (0)
#define PG8_LDA(dst, b, h) do { _Pragma("unroll") for (int m = 0; m < 4; ++m) _Pragma("unroll") for (int k = 0; k < 2; ++k) dst[m][k] = *(const PG8_LAS bf16x8*)(lds + PG8_SA(b, h) + aoff + m * 2048 + k * 1024); } while (0)
#define PG8_LDB(dst, b, h) do { _Pragma("unroll") for (int n = 0; n < 2; ++n) _Pragma("unroll") for (int k = 0; k < 2; ++k) dst[n][k] = *(const PG8_LAS bf16x8*)(lds + PG8_SB(b, h) + boff + n * 2048 + k * 1024); } while (0)
#define PG8_MMA(ai, bj, At, Bt) do { __builtin_amdgcn_s_setprio(1); _Pragma("unroll") for (int m = 0; m < 4; ++m) _Pragma("unroll") for (int n = 0; n < 2; ++n) _Pragma("unroll") for (int k = 0; k < 2; ++k) \
        acc[ai][bj][m][n] = __builtin_amdgcn_mfma_f32_16x16x32_bf16(Bt[n][k], At[m][k], acc[ai][bj][m][n], 0, 0, 0); __builtin_amdgcn_s_setprio(0); } while (0)
#define PG8_WAIT_V(n) asm volatile("s_waitcnt vmcnt(" #n ")" ::: "memory")
#define PG8_WAIT_L(n) asm volatile("s_waitcnt lgkmcnt(" #n ")" ::: "memory")
#define PG8_BAR __builtin_amdgcn_s_barrier()
#define PG8_SCHED __builtin_amdgcn_sched_barrier(0)
    Unit cur, nxt; int ui = 0;
    if (!S.next(0, cur)) return;
    f32x4 acc[2][2][4][2];
#pragma unroll
    for (int a = 0; a < 2; ++a)
#pragma unroll
        for (int b = 0; b < 2; ++b)
#pragma unroll
            for (int m = 0; m < 4; ++m)
#pragma unroll
                for (int n = 0; n < 2; ++n) acc[a][b][m][n] = (f32x4){0.f, 0.f, 0.f, 0.f};
    bf16x8 At[4][2], B0[2][2], B1[2][2];
    const char* cA = (const char*)g.A + (size_t)cur.pm * tstep; const char* cB = (const char*)g.Bt + (size_t)cur.pn * tstep;
    S.a_ready(cur);
    if constexpr (SP2) {
        PG8_STAGE(PG8_SB(0, 0), cB, voffB); PG8_STAGE(PG8_SB(0, 1), cB + hstep, voffB); PG8_STAGE(PG8_SA(0, 0), cA, voffA); PG8_STAGE(PG8_SA(0, 1), cA + hstep, voffA);
        if (wr == 1) PG8_BAR;
        PG8_WAIT_V(2); PG8_BAR;
        PG8_STAGE(PG8_SB(1, 0), cB + kstep, voffB); PG8_STAGE(PG8_SA(1, 0), cA + kstep, voffA); PG8_STAGE(PG8_SB(1, 1), cB + hstep + kstep, voffB);
        PG8_WAIT_V(6); PG8_BAR;
    } else {
        PG8_STAGE(PG8_SB(0, 0), cB, voffB); PG8_STAGE(PG8_SA(0, 0), cA, voffA); PG8_STAGE(PG8_SB(0, 1), cB + hstep, voffB); PG8_STAGE(PG8_SA(0, 1), cA + hstep, voffA);
        if (wr == 1) PG8_BAR;
        PG8_WAIT_V(4); PG8_BAR;
        PG8_STAGE(PG8_SB(1, 0), cB + kstep, voffB); PG8_STAGE(PG8_SA(1, 0), cA + kstep, voffA); PG8_STAGE(PG8_SB(1, 1), cB + hstep + kstep, voffB);
        PG8_WAIT_V(6); PG8_BAR;
    }
    for (;;) {
        const bool has_next = S.next(ui + 1, nxt);
        const char* nA = has_next ? (const char*)g.A + (size_t)nxt.pm * tstep : cA; const char* nB = has_next ? (const char*)g.Bt + (size_t)nxt.pn * tstep : cB;
        for (int t = 0; t < nt; t += 2) {
            const bool last = (t == nt - 2);
            const char* a1 = cA + (size_t)(t + 1) * kstep;
            const char* a2 = last ? nA : cA + (size_t)(t + 2) * kstep; const char* b2 = last ? nB : cB + (size_t)(t + 2) * kstep;
            const char* a3 = a2 + kstep; const char* b3 = b2 + kstep;
            if (last && has_next) S.a_ready(nxt);
            if constexpr (SP2) {
            PG8_LDB(B0, 0, 0); PG8_LDB(B1, 0, 1); PG8_SCHED; PG8_LDA(At, 0, 0); PG8_STAGE(PG8_SA(1, 1), a1 + hstep, voffA);
            PG8_WAIT_V(8); PG8_WAIT_L(0); PG8_BAR; PG8_MMA(0, 0, At, B0); PG8_MMA(0, 1, At, B1); PG8_BAR; PG8_SCHED;
            PG8_LDA(At, 0, 1); PG8_STAGE(PG8_SB(0, 0), b2, voffB); PG8_STAGE(PG8_SB(0, 1), b2 + hstep, voffB); PG8_STAGE(PG8_SA(0, 0), a2, voffA);
            PG8_WAIT_V(8); PG8_WAIT_L(0); PG8_BAR; PG8_MMA(1, 0, At, B0); PG8_MMA(1, 1, At, B1); PG8_BAR; PG8_SCHED;
            PG8_LDB(B0, 1, 0); PG8_LDB(B1, 1, 1); PG8_SCHED; PG8_LDA(At, 1, 0); PG8_STAGE(PG8_SA(0, 1), a2 + hstep, voffA);
            PG8_WAIT_V(8); PG8_WAIT_L(0); PG8_BAR; PG8_MMA(0, 0, At, B0); PG8_MMA(0, 1, At, B1); PG8_BAR; PG8_SCHED;
            PG8_LDA(At, 1, 1); PG8_STAGE(PG8_SB(1, 0), b3, voffB); PG8_STAGE(PG8_SB(1, 1), b3 + hstep, voffB); PG8_STAGE(PG8_SA(1, 0), a3, voffA);
            PG8_WAIT_V(8); PG8_WAIT_L(0); PG8_BAR; PG8_MMA(1, 0, At, B0); PG8_MMA(1, 1, At, B1); PG8_BAR; PG8_SCHED;
            } else {
            PG8_LDB(B0, 0, 0); PG8_SCHED; PG8_LDA(At, 0, 0); PG8_STAGE(PG8_SA(1, 1), a1 + hstep, voffA);
            PG8_WAIT_L(8); PG8_BAR; PG8_WAIT_L(0); PG8_MMA(0, 0, At, B0); PG8_BAR; PG8_SCHED;
            PG8_LDB(B1, 0, 1); PG8_STAGE(PG8_SB(0, 0), b2, voffB);
            PG8_BAR; PG8_WAIT_L(0); PG8_MMA(0, 1, At, B1); PG8_BAR;
            PG8_LDA(At, 0, 1); PG8_STAGE(PG8_SA(0, 0), a2, voffA);
            PG8_BAR; PG8_WAIT_L(0); PG8_MMA(1, 0, At, B0); PG8_BAR; PG8_SCHED;
            PG8_STAGE(PG8_SB(0, 1), b2 + hstep, voffB);
            PG8_WAIT_V(6); PG8_BAR; PG8_MMA(1, 1, At, B1); PG8_BAR;
            PG8_LDB(B0, 1, 0); PG8_SCHED; PG8_LDA(At, 1, 0); PG8_STAGE(PG8_SA(0, 1), a2 + hstep, voffA);
            PG8_WAIT_L(8); PG8_BAR; PG8_WAIT_L(0); PG8_MMA(0, 0, At, B0); PG8_BAR; PG8_SCHED;
            PG8_LDB(B1, 1, 1); PG8_STAGE(PG8_SB(1, 0), b3, voffB);
            PG8_BAR; PG8_WAIT_L(0); PG8_MMA(0, 1, At, B1); PG8_BAR;
            PG8_LDA(At, 1, 1); PG8_STAGE(PG8_SA(1, 0), a3, voffA);
            PG8_BAR; PG8_WAIT_L(0); PG8_MMA(1, 0, At, B0); PG8_BAR; PG8_SCHED;
            PG8_STAGE(PG8_SB(1, 1), b3 + hstep, voffB);
            PG8_WAIT_V(6); PG8_BAR; PG8_MMA(1, 1, At, B1); PG8_BAR;
            }
        }
        if constexpr (ALIGN_EPI) { if (wr == 0) PG8_BAR; }
        if constexpr (!Epi::AFTER_DRAIN) { E(acc, cur, wr, wc, fr, fq); S.done(cur); }
        if (!has_next) break;
#pragma unroll
        for (int a = 0; a < 2; ++a)
#pragma unroll
            for (int b = 0; b < 2; ++b)
#pragma unroll
                for (int m = 0; m < 4; ++m)
#pragma unroll
                    for (int n = 0; n < 2; ++n) acc[a][b][m][n] = (f32x4){0.f, 0.f, 0.f, 0.f};
        cur = nxt; cA = nA; cB = nB; ++ui;
        if constexpr (ALIGN_EPI) { if (wr == 1) PG8_BAR; }
    }
    PG8_WAIT_V(0);
    if constexpr (!ALIGN_EPI) { if (wr == 0) PG8_BAR; }
    PG8_BAR;
    if constexpr (Epi::AFTER_DRAIN) { E.fused(acc, cur, wr, wc, fr, fq, lds, wid, lane); S.done(cur); }
#undef PG8_SA
#undef PG8_SB
#undef PG8_STAGE
#undef PG8_LDA
#undef PG8_LDB
#undef PG8_MMA
#undef PG8_WAIT_V
#undef PG8_WAIT_L
#undef PG8_BAR
#undef PG8_SCHED
}
}
#define GAS __attribute__((address_space(1)))
#define LAS __attribute__((address_space(3)))
typedef unsigned short bf16;
typedef unsigned v4u __attribute__((ext_vector_type(4)));
typedef float f32x4 __attribute__((ext_vector_type(4)));
typedef short bf16x8 __attribute__((ext_vector_type(8)));
typedef GAS unsigned gu32;
typedef GAS unsigned long long gu64;
#define RLX_AGENT __ATOMIC_RELAXED, __HIP_MEMORY_SCOPE_AGENT
#define LDS_WAIT() asm volatile("s_waitcnt lgkmcnt(0)" ::: "memory")
#define VM_WAIT() asm volatile("s_waitcnt vmcnt(0)" ::: "memory")
__device__ __forceinline__ unsigned long long rt() { return __builtin_amdgcn_s_memrealtime(); }
__device__ __forceinline__ unsigned f2bf(float f) { unsigned u = __builtin_bit_cast(unsigned, f); return (u + 0x7fffu + ((u >> 16) & 1u)) >> 16; }
__device__ __forceinline__ unsigned pk2(float lo, float hi) { return f2bf(lo) | (f2bf(hi) << 16); }

#define XB_TMO      128
#define XB_XCNT(j)  (256  + 64 * (j))
#define XB_XSUB(j)  (1280 + 64 * (j))
#define XB_XGEN(j)  (2304 + 64 * (j))
#define XB_TOP      3328
#define XB_TOPGEN   3392
#define XCD_BAR_WORDS 3456
#define XB_SPIN_CAP (1u << 18)

__device__ __forceinline__ unsigned xb_ld(unsigned* p)              { return __hip_atomic_load(p, __ATOMIC_RELAXED, __HIP_MEMORY_SCOPE_AGENT); }
__device__ __forceinline__ unsigned xb_add(unsigned* p, unsigned v) { return __hip_atomic_fetch_add(p, v, __ATOMIC_RELAXED, __HIP_MEMORY_SCOPE_AGENT); }
__device__ __forceinline__ unsigned xb_xcc_id() { return (unsigned)__builtin_amdgcn_s_getreg((3 << 11) | 20) & 0xFu; }
#define XB_SPIN(cond, bar) do { unsigned _sp = 0; while (cond) { __builtin_amdgcn_s_sleep(1); \
    if ((++_sp & 255u) == 0u) { if (xb_ld(&(bar)[XB_TMO])) break; if (_sp > XB_SPIN_CAP) { atomicAdd(&(bar)[XB_TMO], 1u); break; } } } } while (0)

struct XcdBarrier {
    unsigned* bar; unsigned x;
    volatile LAS unsigned* st;
};

__device__ __forceinline__ XcdBarrier xcd_barrier_post(unsigned* bar, volatile LAS unsigned* st) {
    XcdBarrier b; b.bar = bar; b.x = xb_xcc_id(); b.st = st;
    if (threadIdx.x == 0) (void)xb_add(&bar[XB_XCNT(b.x)], 1u);
    return b;
}
__device__ __forceinline__ void xcd_barrier_complete(unsigned* bar, unsigned x, unsigned& nloc, unsigned& nx) {
    const unsigned G = gridDim.x * gridDim.y * gridDim.z;
    unsigned sum, cnt, mine, sp = 0u;
    for (;;) {
        sum = 0u; cnt = 0u; mine = 0u;
#pragma unroll
        for (unsigned j = 0; j < 16; ++j) { const unsigned c = xb_ld(&bar[XB_XCNT(j)]); sum += c; cnt += (c > 0u) ? 1u : 0u; mine = (j == x) ? c : mine; }
        if (sum == G) break;
        __builtin_amdgcn_s_sleep(1);
        if ((++sp & 255u) == 0u) { if (xb_ld(&bar[XB_TMO])) break; if (sp > XB_SPIN_CAP) { atomicAdd(&bar[XB_TMO], 1u); break; } }
    }
    nloc = mine > 0u ? mine : 1u; nx = cnt > 0u ? cnt : 1u;
}

__device__ __forceinline__ void xcd_barrier(const XcdBarrier& b) {
    asm volatile("s_waitcnt vmcnt(0)" ::: "memory");
    __syncthreads();
    if (threadIdx.x == 0) {
        unsigned* bar = b.bar;
        __builtin_amdgcn_s_waitcnt(0);
        unsigned nloc = b.st[0], nx = b.st[1];
        if (nloc == 0u) { xcd_barrier_complete(bar, b.x, nloc, nx); b.st[0] = nloc; b.st[1] = nx; }
        const unsigned old = xb_add(&bar[XB_XSUB(b.x)], 1u);
        const unsigned gen = old / nloc;
        if (old + 1u == (gen + 1u) * nloc) {
            __builtin_amdgcn_fence(__ATOMIC_RELEASE, "agent");
            asm volatile("s_waitcnt vmcnt(0)" ::: "memory");
            const unsigned og = xb_add(&bar[XB_TOP], 1u);
            const unsigned tg = og / nx;
            if (og + 1u == (tg + 1u) * nx) xb_add(&bar[XB_TOPGEN], 1u);
            else XB_SPIN(xb_ld(&bar[XB_TOPGEN]) == tg, bar);
            __builtin_amdgcn_fence(__ATOMIC_ACQUIRE, "agent");
            xb_add(&bar[XB_XGEN(b.x)], 1u);
            asm volatile("s_waitcnt vmcnt(0)" ::: "memory");
        } else {
            XB_SPIN(xb_ld(&bar[XB_XGEN(b.x)]) == gen, bar);
            __builtin_amdgcn_fence(__ATOMIC_ACQUIRE, "agent");
            asm volatile("s_waitcnt vmcnt(0)" ::: "memory");
        }
    }
    __syncthreads();
}

constexpr int DM = 2048, NBATCH = 2, SEQ = 4096, MTOK = 8192, DEPTH = 2, HD = 128;
constexpr int PIN = 6150, NPROJ = 6144, DFF = 8192, NMOD = 12288;
constexpr int C_FQ = 0, C_FK = 768, C_FV = 1536, C_DQ = 2304, C_DK = 3072, C_DV = 3840, C_XQ = 4608, C_XK = 5120, C_XV = 5632;
constexpr float RMS_EPS = 1e-6f;
constexpr int NWAVES = 8;
constexpr size_t MiB = 1u << 20;
constexpr size_t WS_CTL = 0, CTL_ZERO_BYTES = 1 * MiB;
constexpr size_t WS_MOD = 1 * MiB, WS_WF = WS_MOD + 256 * 1024, WS_LOGF = WS_WF + 256 * 1024, WS_FCUM = WS_LOGF + 256 * 1024, WS_LSE = 2 * MiB;
constexpr size_t WS_WTIN = 4 * MiB, WS_WTOUT = 52 * MiB, WS_WT1 = 68 * MiB, WS_WT2 = 132 * MiB;
constexpr size_t WS_H = 196 * MiB, WS_XA = 228 * MiB, WS_PROJ = 292 * MiB, WS_Y = 388 * MiB, WS_U = 292 * MiB;
constexpr size_t WS_ODIL = 420 * MiB, WS_ODIFF = 456 * MiB, WS_SBUF = 472 * MiB, WS_PBUF = 536 * MiB, WS_VT = 568 * MiB, WS_END = 569 * MiB;
constexpr int CW_BAR = 4096;
constexpr int RING_OFF = 0, RING_BYTES = 131072, SCR_BYTES = 139264;
constexpr int LDSCTL_OFF = SCR_BYTES, MISC_OFF = LDSCTL_OFF + 320, LDS_BYTES = 147456;
static_assert(MISC_OFF + 128 <= LDS_BYTES, "LDS map");

__device__ __forceinline__ float bf2f(unsigned v) { return __builtin_bit_cast(float, v << 16); }
__device__ __forceinline__ float wave_sum(float v) {
#pragma unroll
    for (int o = 1; o < 64; o <<= 1) v += __shfl_xor(v, o);
    return v;
}
__device__ __forceinline__ float wave_max(float v) {
#pragma unroll
    for (int o = 1; o < 64; o <<= 1) v = fmaxf(v, __shfl_xor(v, o));
    return v;
}
__device__ __forceinline__ int t5_bucket(int n) {
    if (n < 16) return n;
    return 16 + (n >= 22) + (n >= 30) + (n >= 40) + (n >= 54) + (n >= 73) + (n >= 99) + (n >= 134) + (n >= 182) + (n >= 246) + (n >= 332) + (n >= 450) + (n >= 609) +
           (n >= 825) + (n >= 1117) + (n >= 1513);
}
__device__ __forceinline__ float lam_init_of(int l) { return 0.8f - 0.6f * expf(-0.3f * (float)l); }
__device__ __forceinline__ float lam_of(const float* q1, const float* k1, const float* q2, const float* k2, int l, int lane) {
    const float a = wave_sum(q1[l * 64 + lane] * k1[l * 64 + lane]), b = wave_sum(q2[l * 64 + lane] * k2[l * 64 + lane]);
    return expf(a) - expf(b) + lam_init_of(l);
}

struct Args { const float* in[18]; float* out; unsigned char* ws; int ph_lo, ph_hi, bar_region, pad; };
struct Ctx { LAS unsigned char* lds; int tid, lane, wave, vcu, G; };

__device__ __forceinline__ void transpose_item64(const float* W, int Nsrc, int K, bf16* WT, int nblk, int item, int skip_at, int skip_n, LAS float* scr, int lane) {
    const int kb = item / nblk, nb = item % nblk, k0 = 64 * kb, n0 = 64 * nb, sn0 = n0 + (n0 >= skip_at ? skip_n : 0);
    const float* src = W + (size_t)k0 * Nsrc + sn0 + lane;
#pragma unroll 16
    for (int i = 0; i < 64; ++i) scr[i * 65 + lane] = src[(size_t)i * Nsrc];
    LDS_WAIT(); asm volatile("" ::: "memory");
    const int c = lane & 7, nr = lane >> 3;
#pragma unroll
    for (int j = 0; j < 8; ++j) { const int n = nr + 8 * j; const LAS float* s = scr + (8 * c) * 65 + n;
        v4u o; o.x = pk2(s[0 * 65], s[1 * 65]); o.y = pk2(s[2 * 65], s[3 * 65]); o.z = pk2(s[4 * 65], s[5 * 65]); o.w = pk2(s[6 * 65], s[7 * 65]);
        *(GAS v4u*)(WT + (size_t)(n0 + n) * K + k0 + 8 * c) = o; }
    LDS_WAIT(); asm volatile("" ::: "memory");
}
__device__ __forceinline__ void p0_prologue(const Ctx& C, const Args& a) {
    const float* cvec = a.in[1]; const float* w_ada = a.in[2]; const float* b_ada = a.in[3]; const float* w_in = a.in[5];
    const float* w_out = a.in[12]; const float* w1 = a.in[14]; const float* w2 = a.in[15];
    unsigned char* ws = a.ws;
    {
        LAS float* cl = (LAS float*)C.lds; LAS float* red = (LAS float*)(C.lds + 16384);
        for (int i = C.tid; i < 2 * DM; i += 512) cl[i] = cvec[i];
        __syncthreads();
        const int cq = C.tid % 24, kq = C.tid / 24, Q = (int)blockIdx.x * 24 + cq, l = Q / 3072, col = (Q % 3072) * 4;
        if (blockIdx.x < 256u && kq < 21) {
            const float* w = w_ada + (size_t)l * DM * NMOD + col; f32x4 a0 = {0.f, 0.f, 0.f, 0.f}, a1 = {0.f, 0.f, 0.f, 0.f};
#pragma unroll 7
            for (int k = kq; k < DM; k += 21) { const f32x4 wv = *(const f32x4*)(w + (size_t)k * NMOD); a0 += wv * cl[k]; a1 += wv * cl[DM + k]; }
            LAS float* r = red + (kq * 24 + cq) * 8;
            r[0] = a0[0]; r[1] = a0[1]; r[2] = a0[2]; r[3] = a0[3]; r[4] = a1[0]; r[5] = a1[1]; r[6] = a1[2]; r[7] = a1[3];
        }
        __syncthreads();
        if (blockIdx.x < 256u && C.tid < 192) { const int q = C.tid >> 3, e = C.tid & 7; float s = 0.f;
            for (int g = 0; g < 21; ++g) s += red[(g * 24 + q) * 8 + e];
            const int Qq = (int)blockIdx.x * 24 + q, ll = Qq / 3072, cc = (Qq % 3072) * 4 + (e & 3), b = e >> 2;
            ((float*)(ws + WS_MOD))[((size_t)ll * 2 + b) * NMOD + cc] = s + b_ada[ll * NMOD + cc]; }
        __syncthreads();
    }
    for (int idx = (int)blockIdx.x * 512 + C.tid; idx < DEPTH * 6 * DM; idx += C.G * 512) { const int l = idx / (6 * DM), r = idx % (6 * DM), j = r / DM, k = r % DM;
        ((float*)(ws + WS_WF))[idx] = w_in[((size_t)l * DM + k) * PIN + 2304 + j]; }
    LAS float* scr = (LAS float*)(C.lds + C.wave * 16640);
    const int gw = C.vcu * NWAVES + C.wave, NGW = C.G * NWAVES;
    constexpr int I_IN = (DM / 64) * (NPROJ / 64), I_OUT = (DM / 64) * (DM / 64), I_1 = (DM / 64) * (DFF / 64), I_2 = (DFF / 64) * (DM / 64), I_L = I_IN + I_OUT + I_1 + I_2;
    for (int it = gw; it < DEPTH * I_L; it += NGW) {
        const int l = it / I_L; int r = it % I_L;
        if (r < I_IN) { transpose_item64(w_in + (size_t)l * DM * PIN, PIN, DM, (bf16*)(ws + WS_WTIN) + (size_t)l * NPROJ * DM, NPROJ / 64, r, 2304, 6, scr, C.lane); continue; } r -= I_IN;
        if (r < I_OUT) { transpose_item64(w_out + (size_t)l * DM * DM, DM, DM, (bf16*)(ws + WS_WTOUT) + (size_t)l * DM * DM, DM / 64, r, 1 << 30, 0, scr, C.lane); continue; } r -= I_OUT;
        if (r < I_1) { transpose_item64(w1 + (size_t)l * DM * DFF, DFF, DM, (bf16*)(ws + WS_WT1) + (size_t)l * DFF * DM, DFF / 64, r, 1 << 30, 0, scr, C.lane); continue; } r -= I_1;
        transpose_item64(w2 + (size_t)l * DFF * DM, DM, DFF, (bf16*)(ws + WS_WT2) + (size_t)l * DM * DFF, DM / 64, r, 1 << 30, 0, scr, C.lane);
    }
}
__device__ __forceinline__ void norm_phase(const Ctx& C, const float* x, const float* g, const float* sc, const float* sh, bf16* outb, float* outf,
                                           const float* WF, const float* b_forget, float* logf) {
    LAS f32x4* wfl = (LAS f32x4*)C.lds;
    if (WF) { for (int i = C.tid; i < 6 * DM / 4; i += 512) wfl[i] = ((const f32x4*)WF)[i]; __syncthreads(); }
    const int gw = C.vcu * NWAVES + C.wave, NGW = C.G * NWAVES, lane = C.lane;
    for (int row = gw; row < MTOK; row += NGW) {
        const int b = row / SEQ, s = row % SEQ;
        const float* xr = x + (size_t)row * DM; f32x4 v[8]; float ss = 0.f;
#pragma unroll
        for (int i = 0; i < 8; ++i) { v[i] = *(const f32x4*)(xr + i * 256 + lane * 4); ss += (v[i][0] * v[i][0] + v[i][1] * v[i][1]) + (v[i][2] * v[i][2] + v[i][3] * v[i][3]); }
        const float rstd = rsqrtf(wave_sum(ss) * (1.f / DM) + RMS_EPS);
        float d0 = 0.f, d1 = 0.f, d2 = 0.f, d3 = 0.f, d4 = 0.f, d5 = 0.f;
        const LAS f32x4* wp = wfl; asm volatile("" : "+v"(wp));
#pragma unroll
        for (int i = 0; i < 8; ++i) { const int col = i * 256 + lane * 4; const f32x4 gv = *(const f32x4*)(g + col); f32x4 y = v[i] * rstd * gv;
            if (sc) { const f32x4 s1 = *(const f32x4*)(sc + (size_t)b * NMOD + col), s0 = *(const f32x4*)(sh + (size_t)b * NMOD + col); y = y * (1.f + s1) + s0; }
            if (outf) *(f32x4*)(outf + (size_t)row * DM + col) = y;
            if (outb) *(uint2*)(outb + (size_t)row * DM + col) = make_uint2(pk2(y[0], y[1]), pk2(y[2], y[3]));
            if (WF) { const int q = i * 64 + lane;
#define DOT(j, acc) { const f32x4 wv = wp[(j) * (DM / 4) + q]; acc += (y[0] * wv[0] + y[1] * wv[1]) + (y[2] * wv[2] + y[3] * wv[3]); }
                DOT(0, d0) DOT(1, d1) DOT(2, d2) DOT(3, d3) DOT(4, d4) DOT(5, d5)
#undef DOT
            }
        }
        if (WF) {
#define LS(j, acc) { const float z = wave_sum(acc) + b_forget[j]; const float ls = fminf(z, 0.f) - log1pf(expf(-fabsf(z))); if (lane == 0) logf[((size_t)b * 6 + (j)) * SEQ + s] = ls; }
            LS(0, d0) LS(1, d1) LS(2, d2) LS(3, d3) LS(4, d4) LS(5, d5)
#undef LS
        }
    }
}
__device__ __forceinline__ void cumsum_block(const Ctx& C, const float* logf, float* F, int bh) {
    LAS float* wtot = (LAS float*)(C.lds + MISC_OFF + 64);
    const float* in = logf + (size_t)bh * SEQ + C.tid * 8; float v[8]; float run = 0.f;
#pragma unroll
    for (int i = 0; i < 8; ++i) { run += in[i]; v[i] = run; }
    float incl = run;
#pragma unroll
    for (int o = 1; o < 64; o <<= 1) { const float t = __shfl_up(incl, o); if (C.lane >= o) incl += t; }
    if (C.lane == 63) wtot[C.wave] = incl;
    __syncthreads();
    float off = incl - run;
    for (int w = 0; w < C.wave; ++w) off += wtot[w];
    float* o = F + (size_t)bh * SEQ + C.tid * 8;
#pragma unroll
    for (int i = 0; i < 8; ++i) o[i] = v[i] + off;
    __syncthreads();
}
__device__ __forceinline__ void combine_phase(const Ctx& C, const Args& a, int l) {
    const bf16* od = (const bf16*)(a.ws + WS_ODIL); const float* lse = (const float*)(a.ws + WS_LSE); const bf16* ox = (const bf16*)(a.ws + WS_ODIFF); bf16* Y = (bf16*)(a.ws + WS_Y);
    const int gw = C.vcu * NWAVES + C.wave, NGW = C.G * NWAVES, lane = C.lane;
    for (int it = gw; it < MTOK * 96 / 64; it += NGW) {
        const int idx = it * 64 + lane, row = idx / 96, ch = idx % 96, h = ch >> 4, b = row / SEQ, s = row % SEQ;
        float lv[3]; v4u o[3];
#pragma unroll
        for (int p = 0; p < 3; ++p) { lv[p] = lse[((size_t)p * 12 + b * 6 + h) * SEQ + s]; o[p] = *(const v4u*)(od + ((size_t)p * MTOK + row) * 768 + ch * 8); }
        const float mx = fmaxf(lv[0], fmaxf(lv[1], lv[2])); const float e0 = __expf(lv[0] - mx), e1 = __expf(lv[1] - mx), e2 = __expf(lv[2] - mx); const float inv = 1.f / (e0 + e1 + e2);
        const float w0 = e0 * inv, w1 = e1 * inv, w2 = e2 * inv; v4u r;
#pragma unroll
        for (int q = 0; q < 4; ++q) { const float lo = w0 * bf2f(o[0][q] & 0xffffu) + w1 * bf2f(o[1][q] & 0xffffu) + w2 * bf2f(o[2][q] & 0xffffu);
            const float hi = w0 * bf2f(o[0][q] >> 16) + w1 * bf2f(o[1][q] >> 16) + w2 * bf2f(o[2][q] >> 16); r[q] = pk2(lo, hi); }
        *(v4u*)(Y + (size_t)row * DM + 768 + ch * 8) = r;
    }
    const float lam = lam_of(a.in[7], a.in[8], a.in[9], a.in[10], l, lane), kf = 1.f - lam_init_of(l); const float* subg = a.in[11] + l * 128;
    for (int row = gw; row < MTOK; row += NGW) {
        const v4u u1 = *(const v4u*)(ox + (size_t)row * 512 + lane * 8), u2 = *(const v4u*)(ox + ((size_t)MTOK + row) * 512 + lane * 8);
        float av[8]; float ss = 0.f;
#pragma unroll
        for (int q = 0; q < 4; ++q) { av[2 * q] = bf2f(u1[q] & 0xffffu) - lam * bf2f(u2[q] & 0xffffu); av[2 * q + 1] = bf2f(u1[q] >> 16) - lam * bf2f(u2[q] >> 16); ss += av[2 * q] * av[2 * q] + av[2 * q + 1] * av[2 * q + 1]; }
        ss += __shfl_xor(ss, 1); ss += __shfl_xor(ss, 2); ss += __shfl_xor(ss, 4); ss += __shfl_xor(ss, 8);
        const float rstd = rsqrtf(ss * (1.f / 128.f) + RMS_EPS) * kf; const float* gp = subg + (lane & 15) * 8; v4u r;
#pragma unroll
        for (int q = 0; q < 4; ++q) r[q] = pk2(av[2 * q] * rstd * gp[2 * q], av[2 * q + 1] * rstd * gp[2 * q + 1]);
        *(v4u*)(Y + (size_t)row * DM + 1536 + lane * 8) = r;
    }
}
namespace fa {
typedef float f32x16 __attribute__((ext_vector_type(16)));
typedef short s16x4 __attribute__((ext_vector_type(4)));
constexpr int QBLK = 32, KVBLK = 64, QB = 256;
constexpr int SHM_V = KVBLK * 128 * 2, SHM_K = KVBLK * 128 * 2;
constexpr int L_V = 0, L_K = 2 * SHM_V, L_WS = L_K + 2 * SHM_K, L_BIAS = L_WS + NWAVES * 64 * 4, L_END = L_BIAS + 16384 + 64;
static_assert(L_END <= RING_BYTES, "attention LDS");
#define KSWZ(row, colB) ((row) * 256 + ((colB) ^ (((row) & 7) << 4)))
#define SBAR() __builtin_amdgcn_sched_barrier(0)
__device__ __forceinline__ int v_st(int k, int c) { const int kk = (k & ~0xC) | ((k & 4) << 1) | ((k & 8) >> 1); return ((kk >> 3) * 4 + (c >> 5)) * 512 + ((kk & 7) * 32 + (c & 31)) * 2; }
__device__ __forceinline__ int v_rd_base(int lane) { return ((lane & 3) << 3) | (((lane >> 2) & 3) << 6) | (((lane >> 4) & 1) << 5) | (((lane >> 5) & 1) << 8); }
constexpr int v_rd_off(int d0, int ks, int half) { return d0 * 512 + ks * 4096 + half * 2048; }
__device__ __forceinline__ int crow(int r, int hi) { return (r & 3) + 8 * (r >> 2) + 4 * hi; }
__device__ __forceinline__ unsigned cvtpk(float lo, float hi) { unsigned r; asm volatile("v_cvt_pk_bf16_f32 %0, %1, %2" : "=v"(r) : "v"(lo), "v"(hi)); return r; }
__device__ __forceinline__ void mask_tile(f32x16& p0, f32x16& p1, int dq, unsigned W) {
    const float NEG = -__builtin_inff();
#pragma unroll
    for (int r = 0; r < 16; ++r) { const int c = (r & 3) + 8 * (r >> 2);
        if ((unsigned)(dq - c) >= W) p0[r] = NEG;
        if ((unsigned)(dq - c - 32) >= W) p1[r] = NEG; }
}
template <int MODE> __device__ __forceinline__ void bias_tile(f32x16& p0, f32x16& p1, const LAS float* tb, int dq, int kb, int hi, int tmax) {
    if (MODE == 0) { const LAS f32x4* g = (const LAS f32x4*)(tb + kb + 4 * hi);
#pragma unroll
        for (int q4 = 0; q4 < 4; ++q4) { const f32x4 a = g[2 * q4], b = g[2 * q4 + 8];
#pragma unroll
            for (int j = 0; j < 4; ++j) { p0[4 * q4 + j] += a[j]; p1[4 * q4 + j] += b[j]; } } }
    else {
#pragma unroll
        for (int r = 0; r < 16; ++r) { const int c = (r & 3) + 8 * (r >> 2); int i0 = dq - c, i1 = dq - c - 32;
            i0 = i0 < 0 ? 0 : (i0 > tmax ? tmax : i0); i1 = i1 < 0 ? 0 : (i1 > tmax ? tmax : i1);
            p0[r] += tb[i0]; p1[r] += tb[i1]; } }
}
__device__ __forceinline__ void partialSM(f32x16& p0, f32x16& p1, float& m_reg, float& alpha, float SCALE, float C2, float THR) {
    float pmax = p0[0];
#pragma unroll
    for (int r = 1; r < 16; ++r) pmax = fmaxf(pmax, p0[r]);
#pragma unroll
    for (int r = 0; r < 16; ++r) pmax = fmaxf(pmax, p1[r]);
    { auto rr = __builtin_amdgcn_permlane32_swap(__float_as_uint(pmax), __float_as_uint(pmax), false, false); pmax = fmaxf(__uint_as_float(rr[0]), __uint_as_float(rr[1])); }
    float mn;
    if (__builtin_expect(__all((pmax - m_reg) * SCALE <= THR), 1)) { mn = m_reg; alpha = 1.f; }
    else { mn = fmaxf(m_reg, pmax); alpha = __builtin_amdgcn_exp2f((m_reg - mn) * C2); m_reg = mn; }
    const float mnL = -mn * C2;
#pragma unroll
    for (int r = 0; r < 16; ++r) { p0[r] = __builtin_amdgcn_exp2f(fmaf(p0[r], C2, mnL)); p1[r] = __builtin_amdgcn_exp2f(fmaf(p1[r], C2, mnL)); }
}
__device__ __forceinline__ void finishSM(f32x16& p0, f32x16& p1, float alpha, float& l_reg, bf16x8& pa0, bf16x8& pa1, bf16x8& pa2, bf16x8& pa3) {
    float ps = 0.f;
#pragma unroll
    for (int r = 0; r < 16; ++r) ps += p0[r];
#pragma unroll
    for (int r = 0; r < 16; ++r) ps += p1[r];
    { auto rr = __builtin_amdgcn_permlane32_swap(__float_as_uint(ps), __float_as_uint(ps), false, false); ps = __uint_as_float(rr[0]) + __uint_as_float(rr[1]); }
    l_reg = l_reg * alpha + ps;
#define PK4(P, B_, OUT) do { unsigned a0 = cvtpk(P[B_+0], P[B_+1]), a1 = cvtpk(P[B_+2], P[B_+3]); unsigned b0 = cvtpk(P[B_+4], P[B_+5]), b1 = cvtpk(P[B_+6], P[B_+7]); \
        auto r0 = __builtin_amdgcn_permlane32_swap(a0, b0, false, false); auto r1 = __builtin_amdgcn_permlane32_swap(a1, b1, false, false); \
        v4u w = {r0[0], r1[0], r0[1], r1[1]}; OUT = __builtin_bit_cast(bf16x8, w); } while (0)
    PK4(p0, 0, pa0); PK4(p0, 8, pa1); PK4(p1, 0, pa2); PK4(p1, 8, pa3);
#undef PK4
}
template <int KB, int ND0> __device__ __forceinline__ void qkt(f32x16& p0, f32x16& p1, const LAS unsigned char* K_lds, int r32, int hi, const bf16x8* qr) {
    p0 = f32x16{}; p1 = f32x16{};
    const LAS unsigned char* kb[4];
#pragma unroll
    for (int dd = 0; dd < 4; ++dd) kb[dd] = K_lds + KB * SHM_K + KSWZ(r32, (dd * 16 + hi * 8) * 2);
#pragma unroll
    for (int d0 = 0; d0 < ND0; ++d0) { const LAS unsigned char* a = kb[d0 & 3] + (d0 >> 2) * 128;
        const bf16x8 b0 = *(const LAS bf16x8*)a, b1 = *(const LAS bf16x8*)(a + 32 * 256);
        p0 = __builtin_amdgcn_mfma_f32_32x32x16_bf16(b0, qr[d0], p0, 0, 0, 0);
        p1 = __builtin_amdgcn_mfma_f32_32x32x16_bf16(b1, qr[d0], p1, 0, 0, 0); }
}
template <int VB> __device__ __forceinline__ void pv_tile(f32x16* o, int vb0, bf16x8 pa0, bf16x8 pa1, bf16x8 pa2, bf16x8 pa3) {
#define TRRD(dst, off) asm volatile("ds_read_b64_tr_b16 %0, %1 offset:%2" : "=&v"(dst) : "v"(vb0), "i"(off) : "memory")
#define PV_D0(d0) do { s16x4 l0, l1, l2, l3, h0, h1, h2, h3; constexpr int b_ = VB * SHM_V + v_rd_off(d0, 0, 0); \
        TRRD(l0, b_); TRRD(h0, b_ + 2048); TRRD(l1, b_ + 4096); TRRD(h1, b_ + 6144); TRRD(l2, b_ + 8192); TRRD(h2, b_ + 10240); TRRD(l3, b_ + 12288); TRRD(h3, b_ + 14336); \
        asm volatile("s_waitcnt lgkmcnt(0)" ::: "memory"); SBAR(); \
        o[d0] = __builtin_amdgcn_mfma_f32_32x32x16_bf16(pa0, (bf16x8){l0[0], l0[1], l0[2], l0[3], h0[0], h0[1], h0[2], h0[3]}, o[d0], 0, 0, 0); \
        o[d0] = __builtin_amdgcn_mfma_f32_32x32x16_bf16(pa1, (bf16x8){l1[0], l1[1], l1[2], l1[3], h1[0], h1[1], h1[2], h1[3]}, o[d0], 0, 0, 0); \
        o[d0] = __builtin_amdgcn_mfma_f32_32x32x16_bf16(pa2, (bf16x8){l2[0], l2[1], l2[2], l2[3], h2[0], h2[1], h2[2], h2[3]}, o[d0], 0, 0, 0); \
        o[d0] = __builtin_amdgcn_mfma_f32_32x32x16_bf16(pa3, (bf16x8){l3[0], l3[1], l3[2], l3[3], h3[0], h3[1], h3[2], h3[3]}, o[d0], 0, 0, 0); } while (0)
    PV_D0(0); PV_D0(1); PV_D0(2); PV_D0(3);
#undef PV_D0
#undef TRRD
}
struct Unit {
    const bf16* Q; const bf16* K; const bf16* V;
    long qstride, kstride;
    bf16* O; long ostride;
    float* lse; int lse_stride;
    int q0; unsigned W;
    float scale;
};
#define VMW() asm volatile("s_waitcnt vmcnt(0)" ::: "memory")
template <int MODE> __device__ __forceinline__ void attn_unit(const Unit& u, LAS unsigned char* lds, int tid, int tmax) {
    constexpr int ND0 = MODE == 2 ? 4 : 8;
    const int wid = __builtin_amdgcn_readfirstlane(tid >> 6), lane = tid & 63, r32 = lane & 31, hi = lane >> 5;
    LAS unsigned char* V_lds = lds + L_V; LAS unsigned char* K_lds = lds + L_K;
    LAS float* wsf = (LAS float*)(lds + L_WS) + wid * 64; LAS float* li_l = wsf; LAS float* al_l = wsf + 32;
    const LAS float* tb = (const LAS float*)(lds + L_BIAS);
    const float SCALE = u.scale, C2 = 1.4426950408889634f * SCALE, THR = 0.f;
    const int W = (int)u.W;
    int j_lo = 0; { const int lowk = u.q0 - W + 1; if (lowk > 0) j_lo = lowk / KVBLK; }
    const int j_hi = (u.q0 + QB - 1) / KVBLK + 1, NT = j_hi - j_lo;
    const int qlo = u.q0 + wid * QBLK, qm = qlo + r32 - 4 * hi;
    const int sr = MODE == 2 ? (tid >> 3) : (tid >> 4), sc = MODE == 2 ? (tid & 7) * 8 : (tid & 15) * 8;
    const int kws = KSWZ(sr, sc * 2);
    const int vr = tid >> 4, vc = (tid & 15) * 8, vst0 = v_st(vr, vc), vst1 = v_st(32 + vr, vc);
    const int vb0 = (int)(uintptr_t)V_lds + v_rd_base(lane);
    bf16x8 st_k0, st_k1, st_v0, st_v1;
#define KROW(k0, rr) (u.K + (size_t)((k0) + (rr)) * u.kstride + sc)
#define VROW(k0, rr) (u.V + (size_t)((k0) + (rr)) * u.kstride + vc)
#define SLOAD(k0) do { st_v0 = *(const bf16x8*)VROW(k0, vr); st_v1 = *(const bf16x8*)VROW(k0, 32 + vr); st_k0 = *(const bf16x8*)KROW(k0, sr); if (MODE != 2) st_k1 = *(const bf16x8*)KROW(k0, 32 + sr); } while (0)
#define SWRITE(bf) do { *(LAS bf16x8*)(V_lds + (bf) * SHM_V + vst0) = st_v0; *(LAS bf16x8*)(V_lds + (bf) * SHM_V + vst1) = st_v1; \
        *(LAS bf16x8*)(K_lds + (bf) * SHM_K + kws) = st_k0; if (MODE != 2) *(LAS bf16x8*)(K_lds + (bf) * SHM_K + kws + 32 * 256) = st_k1; } while (0)
#define KBASE(t) ((j_lo + (t)) * KVBLK)
#define ACT(t) (KBASE(t) <= qlo + QBLK - 1 && KBASE(t) + KVBLK - 1 >= qlo - W + 1)
    bf16x8 qr[ND0];
#pragma unroll
    for (int d0 = 0; d0 < ND0; ++d0) qr[d0] = *(const bf16x8*)(u.Q + (size_t)(wid * QBLK + r32) * u.qstride + d0 * 16 + hi * 8);
    SLOAD(KBASE(0)); VMW(); SWRITE(0);
    if (NT > 1) SLOAD(KBASE(1));
    __syncthreads();
    float m_reg = -1e30f, l_reg = 0.f; f32x16 o[4] = {};
    f32x16 p0, p1; float alpha; bf16x8 pa0, pa1, pa2, pa3;
#define STEP(t, BF) do { \
        if (ACT(t)) { const int kb_ = KBASE(t); \
            qkt<BF, ND0>(p0, p1, K_lds, r32, hi, qr); \
            bias_tile<MODE>(p0, p1, tb, qm - kb_, kb_, hi, tmax); \
            if (kb_ + KVBLK - 1 > qlo || kb_ <= qlo + QBLK - 1 - W) mask_tile(p0, p1, qm - kb_, (unsigned)W); \
            partialSM(p0, p1, m_reg, alpha, SCALE, C2, THR); \
            finishSM(p0, p1, alpha, l_reg, pa0, pa1, pa2, pa3); \
            if (__any(alpha < 1.f)) { if (hi == 0) al_l[r32] = alpha; asm volatile("s_waitcnt lgkmcnt(0)" ::: "memory"); \
                _Pragma("unroll") for (int d_ = 0; d_ < 4; ++d_) _Pragma("unroll") for (int r = 0; r < 16; ++r) o[d_][r] *= al_l[crow(r, hi)]; } \
            SBAR(); pv_tile<BF>(o, vb0, pa0, pa1, pa2, pa3); } \
        if ((t) + 1 < NT) { VMW(); SWRITE((BF) ^ 1); if ((t) + 2 < NT) SLOAD(KBASE((t) + 2)); } \
        __syncthreads(); } while (0)
    int t = 0;
    for (; t + 1 < NT; t += 2) { STEP(t, 0); STEP(t + 1, 1); }
    if (t < NT) STEP(t, 0);
    { auto rr = 0; (void)rr; }
    if (hi == 0) li_l[r32] = l_reg;
    asm volatile("s_waitcnt lgkmcnt(0)" ::: "memory");
    if (u.lse && hi == 0) u.lse[(size_t)(wid * QBLK + r32) * u.lse_stride] = m_reg * SCALE + __logf(l_reg);
    bf16* Ow = u.O + (size_t)(wid * QBLK) * u.ostride;
#pragma unroll
    for (int r = 0; r < 16; ++r) { const int orow = crow(r, hi); const float rli = __builtin_amdgcn_rcpf(li_l[orow]);
#pragma unroll
        for (int d0 = 0; d0 < 4; ++d0) { const float v = o[d0][r] * rli; const float vn = __shfl_xor(v, 1);
            if ((r32 & 1) == 0) *(unsigned*)(Ow + (size_t)orow * u.ostride + d0 * 32 + r32) = cvtpk(v, vn); } }
#undef STEP
#undef ACT
#undef KBASE
#undef SWRITE
#undef SLOAD
#undef KROW
#undef VROW
}
#undef VMW
}
constexpr int N_CAUSAL_UNITS = 16 * 28, N_DIL_UNITS = 12 * 48, N_ATTN_UNITS = N_CAUSAL_UNITS + N_DIL_UNITS;
constexpr int CW_QUEUE = 2048;
__device__ __forceinline__ void attn_phase(const Ctx& C, const Args& a, int l) {
    unsigned char* ws = a.ws; const float* rel = a.in[16];
    const bf16* PROJ = (const bf16*)(ws + WS_PROJ); bf16* Y = (bf16*)(ws + WS_Y); bf16* ODIL = (bf16*)(ws + WS_ODIL); bf16* ODIFF = (bf16*)(ws + WS_ODIFF);
    const float* FC = (const float*)(ws + WS_FCUM); float* LSE = (float*)(ws + WS_LSE);
    gu32* head = (gu32*)(ws + WS_CTL) + CW_QUEUE + 64 * l;
    volatile LAS unsigned* qword = (volatile LAS unsigned*)(C.lds + MISC_OFF + 16);
    LAS float* tb = (LAS float*)(C.lds + fa::L_BIAS);
    for (;;) {
        if (C.tid == 0) *qword = __hip_atomic_fetch_add(head, 1u, __ATOMIC_RELAXED, __HIP_MEMORY_SCOPE_AGENT);
        __syncthreads();
        const int idx = (int)*qword;
        __syncthreads();
        if (idx >= N_ATTN_UNITS) break;
        int tid_ = C.tid; asm volatile("" : "+v"(tid_));
        fa::Unit u;
        if (idx < N_CAUSAL_UNITS) {
            const int qb = 15 - idx / 28, r = idx % 28;
            u.q0 = qb * 256; u.W = 1u << 30; u.qstride = NPROJ; u.kstride = NPROJ; u.lse = nullptr; u.lse_stride = 0;
            if (r < 12) {
                const int b = r / 6, h = r % 6; const bf16* pb = PROJ + (size_t)b * SEQ * NPROJ;
                if ((ATTN_MEGA_KINDS & 1) == 0) continue;
                u.Q = pb + (size_t)u.q0 * NPROJ + C_FQ + h * 128; u.K = pb + C_FK + h * 128; u.V = pb + C_FV + h * 128; u.scale = 0.08838834764831845f;
                u.O = Y + ((size_t)b * SEQ + u.q0) * DM + h * 128; u.ostride = DM;
                const float* F = FC + (size_t)(b * 6 + h) * SEQ; const float fref = F[u.q0 + 255], inv = 11.313708498984761f;
                for (int s = tid_; s < u.q0 + 256; s += 512) tb[s] = (fref - F[s]) * inv;
                fa::attn_unit<0>(u, C.lds, tid_, 0);
            } else {
                const int rr = r - 12, b = rr >> 3, h = (rr >> 1) & 3, m = rr & 1; const bf16* pb = PROJ + (size_t)b * SEQ * NPROJ;
                if ((ATTN_MEGA_KINDS & 4) == 0) continue;
                u.Q = pb + (size_t)u.q0 * NPROJ + C_XQ + h * 128 + m * 64; u.K = pb + C_XK + h * 128 + m * 64; u.V = pb + C_XV + h * 128; u.scale = 0.125f;
                u.O = ODIFF + ((size_t)m * MTOK + (size_t)b * SEQ + u.q0) * 512 + h * 128; u.ostride = 512;
                for (int s = tid_; s < 1600; s += 512) tb[s] = rel[t5_bucket(s) * 10 + 6 + h] * 8.f;
                fa::attn_unit<2>(u, C.lds, tid_, 1599);
            }
        } else {
            const int uu = idx - N_CAUSAL_UNITS, bh = uu / 48, rem = uu % 48, p = rem >> 4, wi = rem & 15, b = bh / 6, h = bh % 6;
            if ((ATTN_MEGA_KINDS & 2) == 0) continue;
            const int d = p == 0 ? 1 : (p == 1 ? 4 : 16), res = p == 0 ? 0 : (p == 1 ? (wi >> 2) : wi), i0 = p == 0 ? wi * 256 : (p == 1 ? (wi & 3) * 256 : 0);
            const bf16* pb = PROJ + ((size_t)b * SEQ + res) * NPROJ;
            u.q0 = i0; u.W = 129u; u.qstride = (long)d * NPROJ; u.kstride = (long)d * NPROJ; u.scale = 0.08838834764831845f;
            u.Q = pb + (size_t)i0 * d * NPROJ + C_DQ + h * 128; u.K = pb + C_DK + h * 128; u.V = pb + C_DV + h * 128;
            u.O = ODIL + ((size_t)p * MTOK + (size_t)b * SEQ + (size_t)i0 * d + res) * 768 + h * 128; u.ostride = (long)d * 768;
            u.lse = LSE + ((size_t)p * 12 + b * 6 + h) * SEQ + (size_t)i0 * d + res; u.lse_stride = d;
            for (int s = tid_; s <= 128; s += 512) tb[s] = rel[t5_bucket(s * d) * 10 + h] * 11.313708498984761f;
            fa::attn_unit<1>(u, C.lds, tid_, 128);
        }
    }
}
constexpr int N_PHASES = 2 + 8 * DEPTH;
__global__ void __launch_bounds__(NWAVES * 64, 2) mega(Args args) {
    extern __shared__ __attribute__((aligned(16))) unsigned char lds_raw[];
    Ctx C; C.lds = (LAS unsigned char*)lds_raw; C.tid = threadIdx.x; C.lane = C.tid & 63; C.wave = __builtin_amdgcn_readfirstlane(C.tid >> 6);
    C.G = gridDim.x; { const int bx = blockIdx.x; C.vcu = (C.G % 8 == 0) ? (bx % 8) * (C.G / 8) + bx / 8 : bx; }
    volatile LAS unsigned* MISC = (volatile LAS unsigned*)(C.lds + MISC_OFF);
    for (int u = C.tid; u < (LDS_BYTES - LDSCTL_OFF) / 4; u += NWAVES * 64) ((LAS unsigned*)(C.lds + LDSCTL_OFF))[u] = 0u;
    __syncthreads();
    unsigned char* const ws = args.ws;
    gu32* ctl = (gu32*)(ws + WS_CTL);
    XcdBarrier bar; bar.bar = (unsigned*)(ctl + CW_BAR) + args.bar_region * XCD_BAR_WORDS; bar.x = 0; bar.st = nullptr;
    if (args.ph_hi - args.ph_lo > 1) bar = xcd_barrier_post((unsigned*)(ctl + CW_BAR) + args.bar_region * XCD_BAR_WORDS, MISC + 8);
    float* const MOD = (float*)(ws + WS_MOD); float* const XA = (float*)(ws + WS_XA); bf16* const Hb = (bf16*)(ws + WS_H); bf16* const PROJ = (bf16*)(ws + WS_PROJ);
    bf16* const Y = (bf16*)(ws + WS_Y); bf16* const U = (bf16*)(ws + WS_U);
    const int lo = args.ph_lo, hi = args.ph_hi;
#define IN(p) (lo <= (p) && (p) < hi)
#define SEAM(p) do { if (IN(p) && IN((p) + 1)) xcd_barrier(bar); } while (0)
#define GEMM_BF16(Aptr, Bptr, Nn, Kk, Optr, act) do { pg8::Gemm g{Aptr, Bptr, MTOK, Nn, Kk}; pg8::EpiBf16 E{Optr, Nn, act}; pg8::StaticOrder S; S.init(MTOK, Nn, C.G, (int)blockIdx.x); \
        pg8::gemm_phase<pg8::EpiBf16, pg8::StaticOrder, true, true>(C.lds + RING_OFF, g, S, E, C.tid); } while (0)
#define GEMM_RES(Aptr, Bptr, Kk, baseptr, gateptr) do { pg8::Gemm g{Aptr, Bptr, MTOK, DM, Kk}; pg8::EpiRes E{baseptr, XA, DM, gateptr, NMOD, SEQ}; pg8::StaticOrder S; S.init(MTOK, DM, C.G, (int)blockIdx.x); \
        pg8::gemm_phase<pg8::EpiRes, pg8::StaticOrder, true, true>(C.lds + RING_OFF, g, S, E, C.tid); } while (0)
#define LAYER(l) do { constexpr int P = 1 + 8 * (l); const float* mod = MOD + (size_t)(l) * 2 * NMOD; const float* xcur = (l) == 0 ? args.in[0] : XA; \
        if (IN(P + 0)) norm_phase(C, xcur, args.in[4] + (l) * DM, mod + 1 * DM, mod + 0 * DM, Hb, nullptr, (const float*)(ws + WS_WF) + (size_t)(l) * 6 * DM, args.in[6] + (l) * 6, (float*)(ws + WS_LOGF)); \
        SEAM(P + 0); \
        if (IN(P + 1)) { if (blockIdx.x < 12u) cumsum_block(C, (const float*)(ws + WS_LOGF), (float*)(ws + WS_FCUM), (int)blockIdx.x); \
            GEMM_BF16(Hb, (const bf16*)(ws + WS_WTIN) + (size_t)(l) * NPROJ * DM, NPROJ, DM, PROJ, 0); } \
        SEAM(P + 1); \
        if (IN(P + 2)) { ATTN_PHASE(l); } \
        SEAM(P + 2); \
        if (IN(P + 3)) combine_phase(C, args, (l)); \
        SEAM(P + 3); \
        if (IN(P + 4)) GEMM_RES(Y, (const bf16*)(ws + WS_WTOUT) + (size_t)(l) * DM * DM, DM, xcur, mod + 2 * DM); \
        SEAM(P + 4); \
        if (IN(P + 5)) norm_phase(C, XA, args.in[13] + (l) * DM, mod + 4 * DM, mod + 3 * DM, Hb, nullptr, nullptr, nullptr, nullptr); \
        SEAM(P + 5); \
        if (IN(P + 6)) GEMM_BF16(Hb, (const bf16*)(ws + WS_WT1) + (size_t)(l) * DFF * DM, DFF, DM, U, 1); \
        SEAM(P + 6); \
        if (IN(P + 7)) GEMM_RES(U, (const bf16*)(ws + WS_WT2) + (size_t)(l) * DM * DFF, DFF, XA, mod + 5 * DM); \
        SEAM(P + 7); } while (0)
#if ATTN_IN_MEGA
#define ATTN_PHASE(l) attn_phase(C, args, (l))
#else
#define ATTN_PHASE(l) do { } while (0)
#endif
    if (IN(0)) p0_prologue(C, args);
    SEAM(0);
    LAYER(0);
    LAYER(1);
    if (IN(N_PHASES - 1)) norm_phase(C, XA, args.in[17], nullptr, nullptr, nullptr, args.out, nullptr, nullptr, nullptr);
#undef IN
#undef SEAM
#undef LAYER
}
template <int EPI>
__global__ __launch_bounds__(256) void k_gemm(const bf16* __restrict__ A, int lda, const bf16* __restrict__ Bt, int ldb, int K, void* Cv, int ldc) {
    __shared__ __attribute__((aligned(16))) bf16 sA[128 * 40];
    __shared__ __attribute__((aligned(16))) bf16 sB[128 * 40];
    const int tid = threadIdx.x, lane = tid & 63, w = tid >> 6, wr = w >> 1, wc = w & 1;
    const int m0 = blockIdx.y * 128, n0 = blockIdx.x * 128;
    f32x4 acc[4][4];
#pragma unroll
    for (int i = 0; i < 4; ++i)
#pragma unroll
        for (int j = 0; j < 4; ++j) acc[i][j] = (f32x4){0.f, 0.f, 0.f, 0.f};
    for (int k0 = 0; k0 < K; k0 += 32) {
#pragma unroll
        for (int i = 0; i < 2; ++i) { const int c = tid + i * 256, row = c >> 2, kc = (c & 3) * 8;
            *(v4u*)&sA[row * 40 + kc] = *(const v4u*)&A[(size_t)(m0 + row) * lda + k0 + kc];
            *(v4u*)&sB[row * 40 + kc] = *(const v4u*)&Bt[(size_t)(n0 + row) * ldb + k0 + kc]; }
        __syncthreads();
        bf16x8 a[4], b[4];
#pragma unroll
        for (int i = 0; i < 4; ++i) { a[i] = *(const bf16x8*)&sA[(wr * 64 + i * 16 + (lane & 15)) * 40 + (lane >> 4) * 8]; b[i] = *(const bf16x8*)&sB[(wc * 64 + i * 16 + (lane & 15)) * 40 + (lane >> 4) * 8]; }
#pragma unroll
        for (int i = 0; i < 4; ++i)
#pragma unroll
            for (int j = 0; j < 4; ++j) acc[i][j] = __builtin_amdgcn_mfma_f32_16x16x32_bf16(a[i], b[j], acc[i][j], 0, 0, 0);
        __syncthreads();
    }
#pragma unroll
    for (int i = 0; i < 4; ++i)
#pragma unroll
        for (int j = 0; j < 4; ++j)
#pragma unroll
            for (int r = 0; r < 4; ++r) { const int row = m0 + wr * 64 + i * 16 + (lane >> 4) * 4 + r, col = n0 + wc * 64 + j * 16 + (lane & 15); const float v = acc[i][j][r];
                const size_t o = (size_t)row * ldc + col;
                if (EPI == 0) ((float*)Cv)[o] = v; else ((bf16*)Cv)[o] = (bf16)f2bf(v); }
}
__global__ void k_vT(const bf16* __restrict__ V, int ldv, bf16* __restrict__ VT) {
    __shared__ bf16 t[32][33];
    const int s0 = blockIdx.x * 32, d0 = blockIdx.y * 32;
    for (int i = threadIdx.y; i < 32; i += 8) t[i][threadIdx.x] = V[(size_t)(s0 + i) * ldv + d0 + threadIdx.x];
    __syncthreads();
    for (int i = threadIdx.y; i < 32; i += 8) VT[(size_t)(d0 + i) * SEQ + s0 + threadIdx.x] = t[threadIdx.x][i];
}
template <int MODE>
__global__ __launch_bounds__(256) void k_softmax(const float* __restrict__ S, bf16* __restrict__ P, float scale, const float* __restrict__ F, const float* __restrict__ relh, int dil, float* __restrict__ lse) {
    __shared__ float red[8];
    const int t = blockIdx.x, tid = threadIdx.x, lane = tid & 63, w = tid >> 6;
    float lg[16]; float m = -1e30f;
#pragma unroll
    for (int i = 0; i < 16; ++i) { const int s = tid + 256 * i; const int dl = t - s; bool valid; float bias;
        if (MODE == 0) { valid = dl >= 0; bias = valid ? F[t] - F[s] : 0.f; }
        else if (MODE == 1) { valid = dl >= 0 && (dl % dil) == 0 && (dl / dil) <= 128; bias = valid ? relh[t5_bucket(dl) * 10] : 0.f; }
        else { valid = dl >= 0; bias = valid ? relh[t5_bucket(dl) * 10] : 0.f; }
        lg[i] = valid ? S[(size_t)t * SEQ + s] * scale + bias : -__builtin_inff(); m = fmaxf(m, lg[i]); }
    m = wave_max(m); if (lane == 0) red[w] = m; __syncthreads(); m = fmaxf(fmaxf(red[0], red[1]), fmaxf(red[2], red[3])); __syncthreads();
    float sum = 0.f;
#pragma unroll
    for (int i = 0; i < 16; ++i) { lg[i] = expf(lg[i] - m); sum += lg[i]; }
    sum = wave_sum(sum); if (lane == 0) red[w] = sum; __syncthreads(); sum = (red[0] + red[1]) + (red[2] + red[3]);
    const float inv = 1.f / sum;
#pragma unroll
    for (int i = 0; i < 16; ++i) P[(size_t)t * SEQ + tid + 256 * i] = (bf16)f2bf(lg[i] * inv);
    if (lse && tid == 0) lse[t] = m + logf(sum);
}
static void baseline_attention(const Args& a, hipStream_t stream) {
    char* ws = (char*)a.ws; const float* rel = a.in[16];
    float* FC = (float*)(ws + WS_FCUM); float* LSE = (float*)(ws + WS_LSE); bf16* PROJ = (bf16*)(ws + WS_PROJ); bf16* Y = (bf16*)(ws + WS_Y);
    bf16* ODIL = (bf16*)(ws + WS_ODIL); bf16* ODIFF = (bf16*)(ws + WS_ODIFF); float* SB = (float*)(ws + WS_SBUF); bf16* PB = (bf16*)(ws + WS_PBUF); bf16* VT = (bf16*)(ws + WS_VT);
    const dim3 tb(32, 8);
    for (int b = 0; b < NBATCH; ++b) {
        const bf16* pb = PROJ + (size_t)b * SEQ * NPROJ;
#if !(ATTN_MEGA_KINDS & 1)
        for (int h = 0; h < 6; ++h) {
            k_gemm<0><<<dim3(SEQ / 128, SEQ / 128), 256, 0, stream>>>(pb + C_FQ + h * 128, NPROJ, pb + C_FK + h * 128, NPROJ, 128, SB, SEQ);
            k_vT<<<dim3(SEQ / 32, 4), tb, 0, stream>>>(pb + C_FV + h * 128, NPROJ, VT);
            k_softmax<0><<<SEQ, 256, 0, stream>>>(SB, PB, 0.08838834764831845f, FC + (size_t)(b * 6 + h) * SEQ, nullptr, 1, nullptr);
            k_gemm<1><<<dim3(1, SEQ / 128), 256, 0, stream>>>(PB, SEQ, VT, SEQ, SEQ, Y + (size_t)b * SEQ * DM + h * 128, DM);
        }
#endif
#if !(ATTN_MEGA_KINDS & 2)
        for (int h = 0; h < 6; ++h) {
            k_gemm<0><<<dim3(SEQ / 128, SEQ / 128), 256, 0, stream>>>(pb + C_DQ + h * 128, NPROJ, pb + C_DK + h * 128, NPROJ, 128, SB, SEQ);
            k_vT<<<dim3(SEQ / 32, 4), tb, 0, stream>>>(pb + C_DV + h * 128, NPROJ, VT);
            for (int p = 0; p < 3; ++p) { const int dil = p == 0 ? 1 : (p == 1 ? 4 : 16);
                k_softmax<1><<<SEQ, 256, 0, stream>>>(SB, PB, 0.08838834764831845f, nullptr, rel + h, dil, LSE + ((size_t)p * 12 + b * 6 + h) * SEQ);
                k_gemm<1><<<dim3(1, SEQ / 128), 256, 0, stream>>>(PB, SEQ, VT, SEQ, SEQ, ODIL + ((size_t)p * MTOK + (size_t)b * SEQ) * 768 + h * 128, 768); }
        }
#endif
#if !(ATTN_MEGA_KINDS & 4)
        for (int h = 0; h < 4; ++h) {
            k_vT<<<dim3(SEQ / 32, 4), tb, 0, stream>>>(pb + C_XV + h * 128, NPROJ, VT);
            for (int m = 0; m < 2; ++m) {
                k_gemm<0><<<dim3(SEQ / 128, SEQ / 128), 256, 0, stream>>>(pb + C_XQ + h * 128 + m * 64, NPROJ, pb + C_XK + h * 128 + m * 64, NPROJ, 64, SB, SEQ);
                k_softmax<2><<<SEQ, 256, 0, stream>>>(SB, PB, 0.125f, nullptr, rel + 6 + h, 1, nullptr);
                k_gemm<1><<<dim3(1, SEQ / 128), 256, 0, stream>>>(PB, SEQ, VT, SEQ, SEQ, ODIFF + ((size_t)m * MTOK + (size_t)b * SEQ) * 512 + h * 128, 512); }
        }
#endif
    }
}
static void launch_mega(Args a, int lo, int hi, int& region, hipStream_t stream) {
    a.ph_lo = lo; a.ph_hi = hi; a.bar_region = region++;
    hipLaunchKernelGGL(mega, dim3(256), dim3(NWAVES * 64), LDS_BYTES, stream, a);
    const hipError_t le = hipPeekAtLastError();
    if (le != hipSuccess) fprintf(stderr, "kernel_launch: launch [%d,%d) failed: %s\n", lo, hi, hipGetErrorName(le));
}
extern "C" void kernel_launch(void* const* d_in, const int* in_sizes, int n_in, void* d_out, int out_size, void* d_ws, size_t ws_size, hipStream_t stream) {
    static int ready = 0;
    if (ready == 0) {
        if (n_in != 18 || in_sizes[0] != MTOK * DM || out_size != MTOK * DM || ws_size < WS_END) { fprintf(stderr, "kernel_launch: unexpected shapes / workspace (%d %d %zu)\n", n_in, out_size, ws_size); ready = -1; return; }
        int dev = 0, cus = 0;
        if (hipGetDevice(&dev) != hipSuccess || hipDeviceGetAttribute(&cus, hipDeviceAttributeMultiprocessorCount, dev) != hipSuccess || cus != 256) { fprintf(stderr, "kernel_launch: needs a 256-CU device (got %d)\n", cus); ready = -1; return; }
        if (hipFuncSetAttribute((const void*)mega, hipFuncAttributeMaxDynamicSharedMemorySize, LDS_BYTES) != hipSuccess) { fprintf(stderr, "kernel_launch: hipFuncSetAttribute failed\n"); ready = -1; return; }
        ready = 1;
    }
    if (ready < 0) return;
    if (hipMemsetAsync((char*)d_ws + WS_CTL, 0, CTL_ZERO_BYTES, stream) != hipSuccess) { fprintf(stderr, "kernel_launch: memset failed\n"); return; }
    Args a{};
    for (int i = 0; i < 18; ++i) a.in[i] = (const float*)d_in[i];
    a.out = (float*)d_out; a.ws = (unsigned char*)d_ws;
    int region = 0;
#if ATTN_IN_MEGA && (ATTN_MEGA_KINDS == 7)
    launch_mega(a, 0, N_PHASES, region, stream);
#else
    launch_mega(a, 0, 1, region, stream);
    for (int l = 0; l < DEPTH; ++l) {
        launch_mega(a, 1 + 8 * l, 3 + 8 * l, region, stream);
#if ATTN_IN_MEGA
        launch_mega(a, 3 + 8 * l, 4 + 8 * l, region, stream);
#endif
        baseline_attention(a, stream);
        launch_mega(a, 4 + 8 * l, l == DEPTH - 1 ? N_PHASES : 9 + 8 * l, region, stream);
    }
#endif
}
```
